# Optimizing an MI355X kernel written in HIP

```python
import jax, jax.numpy as jnp
from jax import lax
import numpy as np

D_MODEL = 2048
BATCH = 2
SEQ = 4096
DEPTH = 1

HEAD_DIM = 128
N_HEADS = D_MODEL // HEAD_DIM
N_HEADS_NA = N_HEADS // 2
N_HEADS_DIL = N_HEADS - N_HEADS_NA
D_NA = N_HEADS_NA * HEAD_DIM
D_DIL = N_HEADS_DIL * HEAD_DIM
GRID_W = 64
NA_ROWS_MAX = 8
NA_COLS = 16
DIL_PATTERNS = ((128, 1), (512, 4), (2048, 16))
DIL_BLOCK = 128
ROPE_THETA = 500000.0
ROPE_DIM = HEAD_DIM // 4
D_FF = 5632
N_MOD = 9
EPS = 1e-6
NEG = -1e30

kernel_name = 'hybrid_natten_dilated_macaron_block'


def rms_norm(x, g):
    xf = x.astype(jnp.float32)
    y = xf * lax.rsqrt(jnp.mean(xf * xf, axis=-1, keepdims=True) + EPS)
    return (y * g.astype(jnp.float32)).astype(x.dtype)


def modulate(n, shift, scale):
    return n * (1 + scale[:, None, :]) + shift[:, None, :]


def swiglu(x, w_gate, w_up, w_down):
    return (jax.nn.silu(x @ w_gate) * (x @ w_up)) @ w_down


def rope_tables(seq):
    pos = jnp.arange(seq, dtype=jnp.float32)
    inv = jnp.power(ROPE_THETA, -jnp.arange(0, ROPE_DIM, 2, dtype=jnp.float32) / ROPE_DIM)
    ang = pos[:, None] * inv[None, :]
    return jnp.cos(ang)[:, None, :], jnp.sin(ang)[:, None, :]


def partial_rope(x, cos, sin):
    half = ROPE_DIM // 2
    xf = x.astype(jnp.float32)
    x1, x2, rest = xf[..., :half], xf[..., half:ROPE_DIM], xf[..., ROPE_DIM:]
    out = jnp.concatenate([x1 * cos - x2 * sin, x2 * cos + x1 * sin, rest], axis=-1)
    return out.astype(x.dtype)


def neighbourhood_attention(q, k, v, rpb):
    B, S, H, D = q.shape
    rows = S // GRID_W
    kr = min(NA_ROWS_MAX, rows)
    qg = q.reshape(B, rows, GRID_W, H, D)
    kg = k.reshape(B, rows, GRID_W, H, D)
    vg = v.reshape(B, rows, GRID_W, H, D)
    col = jnp.arange(GRID_W)
    col_start = jnp.clip(col - NA_COLS // 2, 0, GRID_W - NA_COLS)
    col_idx = col_start[:, None] + jnp.arange(NA_COLS)[None, :]
    col_off = col_idx - col[:, None] + (NA_COLS - 1)
    scale = D ** -0.5

    def row_block(r):
        r_start = jnp.clip(r - kr // 2, 0, rows - kr)
        k_rows = lax.dynamic_slice_in_dim(kg, r_start, kr, axis=1)
        v_rows = lax.dynamic_slice_in_dim(vg, r_start, kr, axis=1)
        k_nb = k_rows[:, :, col_idx]
        v_nb = v_rows[:, :, col_idx]
        row_off = r_start + jnp.arange(kr) - r + (NA_ROWS_MAX - 1)
        bias = rpb[:, row_off][:, :, col_off]
        bias = bias.transpose(0, 2, 1, 3)
        q_r = lax.dynamic_index_in_dim(qg, r, axis=1, keepdims=False)
        s = jnp.einsum('bqhd,bkqnhd->bhqkn', q_r, k_nb,
                       preferred_element_type=jnp.float32) * scale
        s = s + bias[None].astype(jnp.float32)
        p = jax.nn.softmax(s.reshape(B, H, GRID_W, kr * NA_COLS), axis=-1)
        p = p.reshape(B, H, GRID_W, kr, NA_COLS).astype(v.dtype)
        return jnp.einsum('bhqkn,bkqnhd->bqhd', p, v_nb)

    out = lax.map(row_block, jnp.arange(rows))
    return out.transpose(1, 0, 2, 3, 4).reshape(B, S, H, D)


def dilated_attention(q, k, v):
    B, S, H, D = q.shape
    nb = S // DIL_BLOCK
    scale = D ** -0.5
    qpos = jnp.arange(DIL_BLOCK)

    def q_block(i):
        t = i * DIL_BLOCK + qpos
        q_b = lax.dynamic_slice_in_dim(q, i * DIL_BLOCK, DIL_BLOCK, axis=1)
        outs, lses = [], []
        for window, dil in DIL_PATTERNS:
            half = window // 2 // dil
            offs = dil * jnp.arange(-half, half + 1)
            idx = t[:, None] + offs[None, :]
            valid = (idx >= 0) & (idx < S)
            idx_c = jnp.clip(idx, 0, S - 1).reshape(-1)
            k_g = jnp.take(k, idx_c, axis=1).reshape(B, DIL_BLOCK, -1, H, D)
            v_g = jnp.take(v, idx_c, axis=1).reshape(B, DIL_BLOCK, -1, H, D)
            s = jnp.einsum('bqhd,bqkhd->bhqk', q_b, k_g,
                           preferred_element_type=jnp.float32) * scale
            s = jnp.where(valid[None, None], s, NEG)
            m = jnp.max(s, axis=-1, keepdims=True)
            e = jnp.exp(s - m)
            den = jnp.sum(e, axis=-1, keepdims=True)
            o = jnp.einsum('bhqk,bqkhd->bqhd', (e / den).astype(v.dtype), v_g)
            outs.append(o)
            lses.append((m + jnp.log(den))[..., 0])
        w = jax.nn.softmax(jnp.stack(lses, axis=0), axis=0)
        w = w.transpose(0, 1, 3, 2).astype(v.dtype)
        return jnp.einsum('pbqh,pbqhd->bqhd', w, jnp.stack(outs, axis=0))

    out = lax.map(q_block, jnp.arange(nb))
    return out.transpose(1, 0, 2, 3, 4).reshape(B, S, H, D)


def setup_inputs(seed: int = 0) -> dict:
    key = jax.random.key(seed)
    ks = jax.random.split(key, 24)
    f32 = jnp.float32
    n = lambda k, shape, s: jax.random.normal(k, shape, f32) * s
    gain = lambda k, shape: 1.0 + 0.02 * jax.random.normal(k, shape, f32)
    L, D = DEPTH, D_MODEL
    return {
        'x': n(ks[0], (BATCH, SEQ, D), 1.0),
        'c': n(ks[1], (BATCH, D), 1.0),
        'w_ada': n(ks[2], (L, D, N_MOD * D), 0.5 * D ** -0.5),
        'b_ada': n(ks[3], (L, N_MOD * D), 0.02),
        'g_ffn1': gain(ks[4], (L, D)),
        'w1_gate': n(ks[5], (L, D, D_FF), D ** -0.5),
        'w1_up': n(ks[6], (L, D, D_FF), D ** -0.5),
        'w1_down': n(ks[7], (L, D_FF, D), D_FF ** -0.5),
        'g_mix': gain(ks[8], (L, D)),
        'w_qkv': n(ks[9], (L, D, 3 * D), D ** -0.5),
        'qn_na': gain(ks[10], (L, HEAD_DIM)),
        'kn_na': gain(ks[11], (L, HEAD_DIM)),
        'qn_dil': gain(ks[12], (L, HEAD_DIM)),
        'kn_dil': gain(ks[13], (L, HEAD_DIM)),
        'rpb_na': n(ks[14], (L, N_HEADS_NA, 2 * NA_ROWS_MAX - 1, 2 * NA_COLS - 1), 0.1),
        'g_out_na': gain(ks[15], (L, D_NA)),
        'g_out_dil': gain(ks[16], (L, D_DIL)),
        'w_o': n(ks[17], (L, D, D), D ** -0.5),
        'g_ffn2': gain(ks[18], (L, D)),
        'w2_gate': n(ks[19], (L, D, D_FF), D ** -0.5),
        'w2_up': n(ks[20], (L, D, D_FF), D ** -0.5),
        'w2_down': n(ks[21], (L, D_FF, D), D_FF ** -0.5),
    }


def reference(x, c, w_ada, b_ada, g_ffn1, w1_gate, w1_up, w1_down, g_mix, w_qkv,
              qn_na, kn_na, qn_dil, kn_dil, rpb_na, g_out_na, g_out_dil, w_o,
              g_ffn2, w2_gate, w2_up, w2_down):
    B, S, D = x.shape
    cos, sin = rope_tables(S)
    h = x
    for l in range(DEPTH):
        mod = jax.nn.silu(c) @ w_ada[l] + b_ada[l]
        sh1, sc1, gt1, sh2, sc2, gt2, sh3, sc3, gt3 = jnp.split(mod, N_MOD, axis=-1)

        f = swiglu(modulate(rms_norm(h, g_ffn1[l]), sh1, sc1), w1_gate[l], w1_up[l], w1_down[l])
        h = h + 0.5 * gt1[:, None, :] * f

        nrm = modulate(rms_norm(h, g_mix[l]), sh2, sc2)
        qkv = nrm @ w_qkv[l]
        q, k, v = jnp.split(qkv, 3, axis=-1)
        q = q.reshape(B, S, N_HEADS, HEAD_DIM)
        k = k.reshape(B, S, N_HEADS, HEAD_DIM)
        v = v.reshape(B, S, N_HEADS, HEAD_DIM)

        qa = rms_norm(q[:, :, :N_HEADS_NA], qn_na[l])
        ka = rms_norm(k[:, :, :N_HEADS_NA], kn_na[l])
        o_na = neighbourhood_attention(qa, ka, v[:, :, :N_HEADS_NA], rpb_na[l])

        qb = partial_rope(rms_norm(q[:, :, N_HEADS_NA:], qn_dil[l]), cos, sin)
        kb = partial_rope(rms_norm(k[:, :, N_HEADS_NA:], kn_dil[l]), cos, sin)
        o_dil = dilated_attention(qb, kb, v[:, :, N_HEADS_NA:])

        o_na = rms_norm(o_na.reshape(B, S, D_NA), g_out_na[l])
        o_dil = rms_norm(o_dil.reshape(B, S, D_DIL), g_out_dil[l])
        mix = jnp.concatenate([o_na, o_dil], axis=-1) @ w_o[l]
        h = h + gt2[:, None, :] * mix

        f = swiglu(modulate(rms_norm(h, g_ffn2[l]), sh3, sc3), w2_gate[l], w2_up[l], w2_down[l])
        h = h + 0.5 * gt3[:, None, :] * f
    return h
```

```cpp
#include <hip/hip_runtime.h>
#include <hip/hip_cooperative_groups.h>
#include <cstdio>
#include <cstdint>
namespace cg = cooperative_groups;

#ifndef PROBE_DUP
#define PROBE_DUP -1
#endif
#ifndef MK_MULTI
#define MK_MULTI 0
#endif

namespace pg8 {
#define PG8_LAS __attribute__((address_space(3)))
typedef unsigned short bf16_t;
typedef short bf16x8 __attribute__((ext_vector_type(8)));
typedef float f32x4 __attribute__((ext_vector_type(4)));
typedef unsigned u32x4 __attribute__((ext_vector_type(4)));
constexpr int BM = 256, BK = 64, HALF = 128, HTB = HALF * BK * 2  , STAGE_BYTES = 8 * HTB, NXCD = 8, WGM = 8;

__host__ __device__ __forceinline__ int lds_byte(int r, int c) { const int st = (r >> 4) * 2 + (c >> 5), rr = r & 15, cc = c & 31, ob = rr * 64 + cc * 2; return st * 1024 + (ob ^ (((ob >> 9) & 1) << 5)); }
__host__ __device__ __forceinline__ void stage_rc(int b, int& R, int& C) { const int st = b / 1024, sb = b % 1024, swz = sb ^ (((sb >> 9) & 1) << 5); R = (st >> 1) * 16 + swz / 64; C = (st & 1) * 32 + (swz % 64) / 2; }
__host__ __device__ __forceinline__ int perm32(int rho) { const int n = rho >> 4, i = rho & 15; return 8 * (i >> 2) + 4 * n + (i & 3); }

struct Unit { int pm, pn; };
struct Gemm { const bf16_t* A; const bf16_t* Bt; int M, N, K; };

struct StaticOrder {
    int nM, nN, nwg, G, c, wgm;
    __host__ __device__ void init(int M, int N, int G_, int c_, int wgm_ = WGM) { nM = M / BM; nN = N / BM; nwg = nM * nN; G = G_; c = c_; wgm = wgm_; }
    __host__ __device__ bool next(int i, Unit& u) const {
        const long L = (long)i * G + c; if (L >= nwg) return false;
        int wgid = (int)L; { const int q = nwg / NXCD, r = nwg % NXCD, xcd = wgid % NXCD, off = wgid / NXCD; wgid = (xcd < r ? xcd * (q + 1) : r * (q + 1) + (xcd - r) * q) + off; }
        const int nig = wgm * nN, gid = wgid / nig, fm = gid * wgm, gsz = (nM - fm) < wgm ? (nM - fm) : wgm;
        u.pm = fm + ((wgid % nig) % gsz); u.pn = (wgid % nig) / gsz; return true;
    }
    __device__ __forceinline__ void a_ready(const Unit&) const {}
    __device__ __forceinline__ void done(const Unit&) const {}
};

__device__ __forceinline__ unsigned cvt_pk_bf16(float lo, float hi) { unsigned r; asm volatile("v_cvt_pk_bf16_f32 %0, %1, %2" : "=v"(r) : "v"(lo), "v"(hi)); return r; }
__device__ __forceinline__ float silu_f(float g) { return g * __builtin_amdgcn_rcpf(1.0f + __builtin_amdgcn_exp2f(-1.4426950408889634f * g)); }

constexpr int EM = 8192, ED = 2048, EFF = 5632, ENMOD = 18432, ESEQ = 4096;

struct EpiSwiGLU {
    static constexpr bool PERM = true, AFTER_DRAIN = false;
    bf16_t* H;
    __device__ __forceinline__ void operator()(const f32x4 (&acc)[2][2][4][2], const Unit& u, int wr, int wc, int fr, int fq) const {
        const int row0 = u.pm * BM + wr * 64 + fr, col0 = u.pn * 128 + wc * 32 + 8 * fq;
#pragma unroll
        for (int ai = 0; ai < 2; ++ai)
#pragma unroll
            for (int m = 0; m < 4; ++m) {
                const int rr = row0 + ai * HALF + m * 16;
                bf16_t* rowp = H + (((size_t)(rr >> 8) * (EFF / 64) + (col0 >> 6)) * 256 + (rr & 255)) * 64 + (col0 & 63);
                const f32x4 g0 = acc[ai][0][m][0], g1 = acc[ai][0][m][1], u0 = acc[ai][1][m][0], u1 = acc[ai][1][m][1];
                u32x4 w;
                w.x = cvt_pk_bf16(silu_f(g0[0]) * u0[0], silu_f(g0[1]) * u0[1]); w.y = cvt_pk_bf16(silu_f(g0[2]) * u0[2], silu_f(g0[3]) * u0[3]);
                w.z = cvt_pk_bf16(silu_f(g1[0]) * u1[0], silu_f(g1[1]) * u1[1]); w.w = cvt_pk_bf16(silu_f(g1[2]) * u1[2], silu_f(g1[3]) * u1[3]);
                *(u32x4*)rowp = w;
            }
    }
};
typedef _Float16 h16x2_t __attribute__((ext_vector_type(2)));
typedef float f32x2e_t __attribute__((ext_vector_type(2)));
__device__ __forceinline__ unsigned pk_h16(float a, float b) { const f32x2e_t v = {a, b}; const h16x2_t h = __builtin_convertvector(v, h16x2_t); return __builtin_bit_cast(unsigned, h); }
__device__ __forceinline__ f32x2e_t up_h16(unsigned w) { const h16x2_t h = __builtin_bit_cast(h16x2_t, w); return __builtin_convertvector(h, f32x2e_t); }
template <bool BIN, bool BOUT, int GS2>
struct EpiResid {
    static constexpr bool PERM = true, AFTER_DRAIN = false;
    const void* base; void* out; const float* gate;
    __device__ __forceinline__ void operator()(const f32x4 (&acc)[2][2][4][2], const Unit& u, int wr, int wc, int fr, int fq) const {
        const int row0 = u.pm * BM + wr * 64 + fr, col0 = u.pn * BM + wc * 32 + 8 * fq, b = u.pm >> 4;
        f32x4 gv[2][2];
#pragma unroll
        for (int bj = 0; bj < 2; ++bj)
#pragma unroll
            for (int n = 0; n < 2; ++n) gv[bj][n] = *(const f32x4*)(gate + (size_t)b * ENMOD + col0 + bj * HALF + 4 * n) * (0.5f * GS2);
#pragma unroll
        for (int ai = 0; ai < 2; ++ai) {
            f32x4 bsf[4][2][2]; u32x4 bsw[4][2];
#pragma unroll
            for (int m = 0; m < 4; ++m) { const size_t off = (size_t)(row0 + ai * HALF + m * 16) * ED + col0;
#pragma unroll
                for (int bj = 0; bj < 2; ++bj) { const size_t o2 = off + bj * HALF;
                    if (BIN) bsw[m][bj] = __builtin_nontemporal_load((const u32x4*)((const bf16_t*)base + o2));
                    else { bsf[m][bj][0] = __builtin_nontemporal_load((const f32x4*)((const float*)base + o2)); bsf[m][bj][1] = __builtin_nontemporal_load((const f32x4*)((const float*)base + o2 + 4)); } } }
#pragma unroll
            for (int m = 0; m < 4; ++m) { const size_t off = (size_t)(row0 + ai * HALF + m * 16) * ED + col0;
#pragma unroll
                for (int bj = 0; bj < 2; ++bj) { const size_t o2 = off + bj * HALF; f32x4 b0, b1;
                    if (BIN) { const u32x4 w = bsw[m][bj];
                        const f32x2e_t u0 = up_h16(w.x), u1 = up_h16(w.y), u2 = up_h16(w.z), u3 = up_h16(w.w);
                        b0 = (f32x4){u0.x, u0.y, u1.x, u1.y}; b1 = (f32x4){u2.x, u2.y, u3.x, u3.y}; }
                    else { b0 = bsf[m][bj][0]; b1 = bsf[m][bj][1]; }
                    const f32x4 h0 = b0 + gv[bj][0] * acc[ai][bj][m][0], h1 = b1 + gv[bj][1] * acc[ai][bj][m][1];
                    if (BOUT) { u32x4 w; w.x = pk_h16(h0[0], h0[1]); w.y = pk_h16(h0[2], h0[3]); w.z = pk_h16(h1[0], h1[1]); w.w = pk_h16(h1[2], h1[3]); *(u32x4*)((bf16_t*)out + o2) = w; }
                    else { __builtin_nontemporal_store(h0, (f32x4*)((float*)out + o2)); __builtin_nontemporal_store(h1, (f32x4*)((float*)out + o2 + 4)); } } }
            asm volatile("" ::: "memory");
        }
    }
};
struct EpiQKV {
    static constexpr bool PERM = true, AFTER_DRAIN = false;
    bf16_t* QKV; float* ssq; const float* gains; const float* rope;
    __device__ __forceinline__ void operator()(const f32x4 (&acc)[2][2][4][2], const Unit& u, int wr, int wc, int fr, int fq) const {
        const int row0 = u.pm * BM + wr * 64 + fr;
        const int kind = u.pn >> 3, pl = u.pn & 7;
        bf16_t* dst = QKV + (size_t)kind * ((size_t)EM * ED);
        const int cbase = pl * 256 + wc * 32 + 8 * fq;
        if (kind == 2) {
#pragma unroll
            for (int ai = 0; ai < 2; ++ai)
#pragma unroll
                for (int m = 0; m < 4; ++m) { bf16_t* rowp = dst + (size_t)(row0 + ai * HALF + m * 16) * ED + cbase;
#pragma unroll
                    for (int bj = 0; bj < 2; ++bj) { const f32x4 v0 = acc[ai][bj][m][0], v1 = acc[ai][bj][m][1]; u32x4 w;
                        w.x = cvt_pk_bf16(v0[0], v0[1]); w.y = cvt_pk_bf16(v0[2], v0[3]); w.z = cvt_pk_bf16(v1[0], v1[1]); w.w = cvt_pk_bf16(v1[2], v1[3]);
                        *(u32x4*)(rowp + bj * HALF) = w; } }
            return;
        }
        const bool dil = pl >= 4;
        const float* gn = gains + (kind * 2 + (dil ? 1 : 0)) * 128;
        f32x4 g0, g1;
        if (wc == 0) { g0 = *(const f32x4*)(gn + 4 * fq); g1 = *(const f32x4*)(gn + 16 + 4 * fq); }
        else { g0 = *(const f32x4*)(gn + wc * 32 + 8 * fq); g1 = *(const f32x4*)(gn + wc * 32 + 8 * fq + 4); }
        const bool do_rope = dil && wc == 0;
#pragma unroll
        for (int ai = 0; ai < 2; ++ai)
#pragma unroll
            for (int m = 0; m < 4; ++m) {
                const int row = row0 + ai * HALF + m * 16;
                f32x4 cs0 = {1.f, 0.f, 1.f, 0.f}, cs1 = {1.f, 0.f, 1.f, 0.f};
                if (do_rope) { const float* rp = rope + ((size_t)(row & (ESEQ - 1)) * 16 + 4 * fq) * 2; cs0 = *(const f32x4*)rp; cs1 = *(const f32x4*)(rp + 4); }
#pragma unroll
                for (int bj = 0; bj < 2; ++bj) {
                    const f32x4 r0 = acc[ai][bj][m][0], r1 = acc[ai][bj][m][1];
                    float ss = (r0[0] * r0[0] + r0[1] * r0[1]) + (r0[2] * r0[2] + r0[3] * r0[3]) + (r1[0] * r1[0] + r1[1] * r1[1]) + (r1[2] * r1[2] + r1[3] * r1[3]);
                    ss += __shfl_xor(ss, 16); ss += __shfl_xor(ss, 32);
                    const int head = 2 * pl + bj;
                    if (fq == 0) ssq[(size_t)(wc * 32 + kind * 16 + head) * EM + row] = ss;
                    f32x4 x1 = r0 * g0, x2 = r1 * g1;
                    if (do_rope) {
                        const f32x4 c = {cs0[0], cs0[2], cs1[0], cs1[2]}, s = {cs0[1], cs0[3], cs1[1], cs1[3]};
                        const f32x4 y1 = x1 * c - x2 * s, y2 = x2 * c + x1 * s; x1 = y1; x2 = y2;
                    }
                    u32x4 w; w.x = cvt_pk_bf16(x1[0], x1[1]); w.y = cvt_pk_bf16(x1[2], x1[3]); w.z = cvt_pk_bf16(x2[0], x2[1]); w.w = cvt_pk_bf16(x2[2], x2[3]);
                    *(u32x4*)(dst + (size_t)row * ED + cbase + bj * HALF) = w;
                }
            }
    }
};

template <class Epi, class Sched, bool ALIGN_EPI = false, bool SP2 = false, bool BLKA = false, bool BLKB = false>
__device__ __forceinline__ void gemm_phase(PG8_LAS unsigned char* lds, const Gemm g, const Sched& S, const Epi& E) {
    const int tid = threadIdx.x, wid = __builtin_amdgcn_readfirstlane(tid >> 6), lane = tid & 63, wr = wid >> 2, wc = wid & 3, fr = lane & 15, fq = lane >> 4;
    const int K = g.K, nt = K / BK;
    unsigned voffA[2], voffB[2];
#pragma unroll
    for (int i = 0; i < 2; ++i) { int R, C; stage_rc(tid * 16 + i * 8192, R, C); const int Rb = Epi::PERM ? ((R & ~31) + perm32(R & 31)) : R;
        voffA[i] = (unsigned)(R * (BLKA ? BK : K) + C) * 2u; voffB[i] = (unsigned)(Rb * (BLKB ? BK : K) + C) * 2u; }
    const size_t kstepA = BLKA ? (size_t)(BM * BK * 2) : (size_t)(BK * 2), kstepB = BLKB ? (size_t)(BM * BK * 2) : (size_t)(BK * 2);
    const size_t hstepA = BLKA ? (size_t)(HALF * BK * 2) : (size_t)HALF * K * 2, hstepB = BLKB ? (size_t)(HALF * BK * 2) : (size_t)HALF * K * 2;
    const size_t tstep = (size_t)BM * K * 2;
    const unsigned ldsw = (unsigned)wid * 1024u;
    const int aoff = lds_byte(wr * 64 + fr, fq * 8), boff = lds_byte(wc * 32 + fr, fq * 8);
#define PG8_SA(b, h) (((b) * 2 + (h)) * HTB)
#define PG8_SB(b, h) ((4 + (b) * 2 + (h)) * HTB)
#define PG8_STAGE(bufoff, gbase, voff) do { _Pragma("unroll") for (int _i = 0; _i < 2; ++_i) \
        __builtin_amdgcn_global_load_lds((const unsigned*)((const char*)(gbase) + (voff)[_i]), (PG8_LAS unsigned*)(lds + (bufoff) + ldsw + _i * 8192), 16, 0, 0); } while (0)
#define PG8_LDA(dst, b, h) do { _Pragma("unroll") for (int m = 0; m < 4; ++m) _Pragma("unroll") for (int k = 0; k < 2; ++k) dst[m][k] = *(const PG8_LAS bf16x8*)(lds + PG8_SA(b, h) + aoff + m * 2048 + k * 1024); } while (0)
#define PG8_LDB(dst, b, h) do { _Pragma("unroll") for (int n = 0; n < 2; ++n) _Pragma("unroll") for (int k = 0; k < 2; ++k) dst[n][k] = *(const PG8_LAS bf16x8*)(lds + PG8_SB(b, h) + boff + n * 2048 + k * 1024); } while (0)
#define PG8_MMA(ai, bj, At, Bt) do { __builtin_amdgcn_s_setprio(1); _Pragma("unroll") for (int m = 0; m < 4; ++m) _Pragma("unroll") for (int n = 0; n < 2; ++n) _Pragma("unroll") for (int k = 0; k < 2; ++k) \
        acc[ai][bj][m][n] = __builtin_amdgcn_mfma_f32_16x16x32_bf16(Bt[n][k], At[m][k], acc[ai][bj][m][n], 0, 0, 0); __builtin_amdgcn_s_setprio(0); } while (0)
#define PG8_WAIT_V(n) asm volatile("s_waitcnt vmcnt(" #n ")" ::: "memory")
#define PG8_WAIT_L(n) asm volatile("s_waitcnt lgkmcnt(" #n ")" ::: "memory")
#define PG8_BAR __builtin_amdgcn_s_barrier()
#define PG8_SCHED __builtin_amdgcn_sched_barrier(0)
    Unit cur, nxt; int ui = 0;
    if (!S.next(0, cur)) return;
    f32x4 acc[2][2][4][2];
#pragma unroll
    for (int a = 0; a < 2; ++a)
#pragma unroll
        for (int b = 0; b < 2; ++b)
#pragma unroll
            for (int m = 0; m < 4; ++m)
#pragma unroll
                for (int n = 0; n < 2; ++n) acc[a][b][m][n] = (f32x4){0.f, 0.f, 0.f, 0.f};
    bf16x8 At[4][2], B0[2][2], B1[2][2];
    const char* cA = (const char*)g.A + (size_t)cur.pm * tstep; const char* cB = (const char*)g.Bt + (size_t)cur.pn * tstep;
    S.a_ready(cur);
    if constexpr (SP2) {
        PG8_STAGE(PG8_SB(0, 0), cB, voffB); PG8_STAGE(PG8_SB(0, 1), cB + hstepB, voffB); PG8_STAGE(PG8_SA(0, 0), cA, voffA); PG8_STAGE(PG8_SA(0, 1), cA + hstepA, voffA);
        if (wr == 1) PG8_BAR;
        PG8_WAIT_V(2); PG8_BAR;
        PG8_STAGE(PG8_SB(1, 0), cB + kstepB, voffB); PG8_STAGE(PG8_SA(1, 0), cA + kstepA, voffA); PG8_STAGE(PG8_SB(1, 1), cB + hstepB + kstepB, voffB);
        PG8_WAIT_V(6); PG8_BAR;
    } else {
        PG8_STAGE(PG8_SB(0, 0), cB, voffB); PG8_STAGE(PG8_SA(0, 0), cA, voffA); PG8_STAGE(PG8_SB(0, 1), cB + hstepB, voffB); PG8_STAGE(PG8_SA(0, 1), cA + hstepA, voffA);
        if (wr == 1) PG8_BAR;
        PG8_WAIT_V(4); PG8_BAR;
        PG8_STAGE(PG8_SB(1, 0), cB + kstepB, voffB); PG8_STAGE(PG8_SA(1, 0), cA + kstepA, voffA); PG8_STAGE(PG8_SB(1, 1), cB + hstepB + kstepB, voffB);
        PG8_WAIT_V(6); PG8_BAR;
    }
    for (;;) {
        const bool has_next = S.next(ui + 1, nxt);
        const char* nA = has_next ? (const char*)g.A + (size_t)nxt.pm * tstep : cA; const char* nB = has_next ? (const char*)g.Bt + (size_t)nxt.pn * tstep : cB;
        for (int t = 0; t < nt; t += 2) {
            const bool last = (t == nt - 2);
            const char* a1 = cA + (size_t)(t + 1) * kstepA;
            const char* a2 = last ? nA : cA + (size_t)(t + 2) * kstepA; const char* b2 = last ? nB : cB + (size_t)(t + 2) * kstepB;
            const char* a3 = a2 + kstepA; const char* b3 = b2 + kstepB;
            if (last && has_next) S.a_ready(nxt);
            if constexpr (SP2) {
            PG8_LDB(B0, 0, 0); PG8_LDB(B1, 0, 1); PG8_SCHED; PG8_LDA(At, 0, 0); PG8_STAGE(PG8_SA(1, 1), a1 + hstepA, voffA);
            PG8_WAIT_V(8); PG8_WAIT_L(0); PG8_BAR; PG8_MMA(0, 0, At, B0); PG8_MMA(0, 1, At, B1); PG8_BAR; PG8_SCHED;
            PG8_LDA(At, 0, 1); PG8_STAGE(PG8_SB(0, 0), b2, voffB); PG8_STAGE(PG8_SB(0, 1), b2 + hstepB, voffB); PG8_STAGE(PG8_SA(0, 0), a2, voffA);
            PG8_WAIT_V(8); PG8_WAIT_L(0); PG8_BAR; PG8_MMA(1, 0, At, B0); PG8_MMA(1, 1, At, B1); PG8_BAR; PG8_SCHED;
            PG8_LDB(B0, 1, 0); PG8_LDB(B1, 1, 1); PG8_SCHED; PG8_LDA(At, 1, 0); PG8_STAGE(PG8_SA(0, 1), a2 + hstepA, voffA);
            PG8_WAIT_V(8); PG8_WAIT_L(0); PG8_BAR; PG8_MMA(0, 0, At, B0); PG8_MMA(0, 1, At, B1); PG8_BAR; PG8_SCHED;
            PG8_LDA(At, 1, 1); PG8_STAGE(PG8_SB(1, 0), b3, voffB); PG8_STAGE(PG8_SB(1, 1), b3 + hstepB, voffB); PG8_STAGE(PG8_SA(1, 0), a3, voffA);
            PG8_WAIT_V(8); PG8_WAIT_L(0); PG8_BAR; PG8_MMA(1, 0, At, B0); PG8_MMA(1, 1, At, B1); PG8_BAR; PG8_SCHED;
            } else {
            PG8_LDB(B0, 0, 0); PG8_SCHED; PG8_LDA(At, 0, 0); PG8_STAGE(PG8_SA(1, 1), a1 + hstepA, voffA);
            PG8_WAIT_L(8); PG8_BAR; PG8_WAIT_L(0); PG8_MMA(0, 0, At, B0); PG8_BAR; PG8_SCHED;
            PG8_LDB(B1, 0, 1); PG8_STAGE(PG8_SB(0, 0), b2, voffB);
            PG8_BAR; PG8_WAIT_L(0); PG8_MMA(0, 1, At, B1); PG8_BAR;
            PG8_LDA(At, 0, 1); PG8_STAGE(PG8_SA(0, 0), a2, voffA);
            PG8_BAR; PG8_WAIT_L(0); PG8_MMA(1, 0, At, B0); PG8_BAR; PG8_SCHED;
            PG8_STAGE(PG8_SB(0, 1), b2 + hstepB, voffB);
            PG8_WAIT_V(6); PG8_BAR; PG8_MMA(1, 1, At, B1); PG8_BAR;
            PG8_LDB(B0, 1, 0); PG8_SCHED; PG8_LDA(At, 1, 0); PG8_STAGE(PG8_SA(0, 1), a2 + hstepA, voffA);
            PG8_WAIT_L(8); PG8_BAR; PG8_WAIT_L(0); PG8_MMA(0, 0, At, B0); PG8_BAR; PG8_SCHED;
            PG8_LDB(B1, 1, 1); PG8_STAGE(PG8_SB(1, 0), b3, voffB);
            PG8_BAR; PG8_WAIT_L(0); PG8_MMA(0, 1, At, B1); PG8_BAR;
            PG8_LDA(At, 1, 1); PG8_STAGE(PG8_SA(1, 0), a3, voffA);
            PG8_BAR; PG8_WAIT_L(0); PG8_MMA(1, 0, At, B0); PG8_BAR; PG8_SCHED;
            PG8_STAGE(PG8_SB(1, 1), b3 + hstepB, voffB);
            PG8_WAIT_V(6); PG8_BAR; PG8_MMA(1, 1, At, B1); PG8_BAR;
            }
        }
        if constexpr (ALIGN_EPI) { if (wr == 0) PG8_BAR; }
        if constexpr (!Epi::AFTER_DRAIN) { E(acc, cur, wr, wc, fr, fq); S.done(cur); }
        if (!has_next) break;
#pragma unroll
        for (int a = 0; a < 2; ++a)
#pragma unroll
            for (int b = 0; b < 2; ++b)
#pragma unroll
                for (int m = 0; m < 4; ++m)
#pragma unroll
                    for (int n = 0; n < 2; ++n) acc[a][b][m][n] = (f32x4){0.f, 0.f, 0.f, 0.f};
        cur = nxt; cA = nA; cB = nB; ++ui;
        if constexpr (ALIGN_EPI) { if (wr == 1) PG8_BAR; }
    }
    PG8_WAIT_V(0);
    if constexpr (!ALIGN_EPI) { if (wr == 0) PG8_BAR; }
    PG8_BAR;
    if constexpr (Epi::AFTER_DRAIN) { E.fused(acc, cur, wr, wc, fr, fq, lds, wid, lane); S.done(cur); }
#undef PG8_SA
#undef PG8_SB
#undef PG8_STAGE
#undef PG8_LDA
#undef PG8_LDB
#undef PG8_MMA
#undef PG8_WAIT_V
#undef PG8_WAIT_L
#undef PG8_BAR
#undef PG8_SCHED
}
}
using pg8::bf16_t; using pg8::bf16x8; using pg8::f32x4; using pg8::u32x4;
#define LAS __attribute__((address_space(3)))
typedef short s16x4 __attribute__((ext_vector_type(4)));
typedef float f32x2_t __attribute__((ext_vector_type(2))); typedef __bf16 bf16x2_t __attribute__((ext_vector_type(2)));
typedef unsigned u32x2 __attribute__((ext_vector_type(2)));
__device__ __forceinline__ unsigned cvtpk_s(float lo, float hi) { f32x2_t v = {lo, hi}; bf16x2_t b = __builtin_convertvector(v, bf16x2_t); return __builtin_bit_cast(unsigned, b); }
__device__ __forceinline__ float bf2f(unsigned short h) { return __uint_as_float((unsigned)h << 16); }
__device__ __forceinline__ float bflo(unsigned w) { return __uint_as_float(w << 16); }
__device__ __forceinline__ float bfhi(unsigned w) { return __uint_as_float(w & 0xffff0000u); }
__device__ __forceinline__ float wave_sum(float v) {
#pragma unroll
    for (int o = 1; o < 64; o <<= 1) v += __shfl_xor(v, o);
    return v;
}

constexpr int M_ = 8192, D_ = 2048, FF_ = 5632, SEQ_ = 4096, NMOD_ = 18432;
constexpr float EPS_ = 1e-6f;
constexpr size_t MiB = 1u << 20;
constexpr size_t WS_MOD = 0;
constexpr size_t WS_BAR = 160 * 1024;
constexpr size_t WS_ZERO_BYTES = 256 * 1024;
constexpr int MISC_OFF = 147456 - 64;
constexpr size_t WS_ROPE = 1 * MiB;
constexpr size_t WS_GAIN = 1 * MiB + 512 * 1024;
constexpr size_t WS_SSQ = 2 * MiB;
constexpr size_t WS_LSE = 6 * MiB;
constexpr size_t WS_WGU1 = 8 * MiB, WS_WD1 = 52 * MiB, WS_WQKV = 74 * MiB, WS_WO = 98 * MiB, WS_WGU2 = 106 * MiB, WS_WD2 = 150 * MiB;
constexpr size_t WS_A = 172 * MiB;
constexpr size_t WS_H = 204 * MiB;
constexpr size_t WS_Q = 292 * MiB, WS_K = 324 * MiB, WS_V = 356 * MiB;
constexpr size_t WS_ONA = 388 * MiB;
constexpr size_t WS_ODIL = 404 * MiB;
constexpr size_t WS_HB = 452 * MiB;
constexpr size_t WS_END = 484 * MiB;
constexpr int LDS_BYTES = 147456;
constexpr int NWAVES = 8;

__device__ __forceinline__ int pos_of(int d) { return d < 16 ? 8 * (d >> 2) + (d & 3) : 8 * ((d - 16) >> 2) + 4 + (d & 3); }
__device__ __forceinline__ void tr_item(const float* __restrict__ W, int K, int N, bf16_t* WT, int mode, LAS float* scr, int item, int lane, bool blk = false) {
    const int nblk = N / 32, kb = item / nblk, nb = item - kb * nblk, k0 = 64 * kb, n0 = 32 * nb;
#pragma unroll 16
    for (int i = 0; i < 32; ++i) { const int kk = 2 * i + (lane >> 5); scr[kk * 33 + (lane & 31)] = W[(size_t)(k0 + kk) * N + n0 + (lane & 31)]; }
    asm volatile("s_waitcnt lgkmcnt(0)" ::: "memory");
    const int c = lane & 7;
    int rb = n0; bool perm = false;
    if (mode == 1) rb = ((n0 >> 7) << 8) + (n0 & 127); else if (mode == 2) rb = ((n0 >> 7) << 8) + 128 + (n0 & 127); else if (mode == 3) perm = (n0 < 4096) && ((n0 & 127) == 0);
#pragma unroll
    for (int j = 0; j < 4; ++j) { const int n = (lane >> 3) + 8 * j; const LAS float* s = scr + (8 * c) * 33 + n;
        u32x4 o; o.x = cvtpk_s(s[0 * 33], s[1 * 33]); o.y = cvtpk_s(s[2 * 33], s[3 * 33]); o.z = cvtpk_s(s[4 * 33], s[5 * 33]); o.w = cvtpk_s(s[6 * 33], s[7 * 33]);
        const int dr = rb + (perm ? pos_of(n) : n);
        const size_t di = blk ? ((((size_t)(dr >> 8) * (K >> 6) + (k0 >> 6)) * 256 + (dr & 255)) * 64 + 8 * c) : ((size_t)dr * K + k0 + 8 * c);
        *(u32x4*)(WT + di) = o; }
    asm volatile("s_waitcnt lgkmcnt(0)" ::: "memory");
}
__device__ __forceinline__ void mod_item(const float* __restrict__ cvec, const float* __restrict__ w_ada, const float* __restrict__ b_ada, float* mod, int item, int lane, int cg0 = 0, int ncg = 72) {
    const int cg_ = cg0 + item % ncg, kc = item / ncg, col = cg_ * 256 + lane * 4;
    const float* W = w_ada + (size_t)(kc * 128) * NMOD_ + col;
    f32x4 a0 = {0.f, 0.f, 0.f, 0.f}, a1 = {0.f, 0.f, 0.f, 0.f};
    for (int k = 0; k < 128; k += 8) {
        f32x4 w[8];
#pragma unroll
        for (int j = 0; j < 8; ++j) w[j] = __builtin_nontemporal_load((const f32x4*)(W + (size_t)(k + j) * NMOD_));
#pragma unroll
        for (int j = 0; j < 8; ++j) { const float c0 = pg8::silu_f(cvec[kc * 128 + k + j]), c1 = pg8::silu_f(cvec[D_ + kc * 128 + k + j]); a0 += w[j] * c0; a1 += w[j] * c1; }
    }
    if (kc == 0) { const f32x4 bb = *(const f32x4*)(b_ada + col); a0 += bb; a1 += bb; }
#pragma unroll
    for (int i = 0; i < 4; ++i) { __hip_atomic_fetch_add(mod + col + i, a0[i], __ATOMIC_RELAXED, __HIP_MEMORY_SCOPE_AGENT); __hip_atomic_fetch_add(mod + NMOD_ + col + i, a1[i], __ATOMIC_RELAXED, __HIP_MEMORY_SCOPE_AGENT); }
}
__device__ const float ROPE_INV[16] = {1.0f, 0.44036659598350525f, 0.1939227432012558f, 0.08539710193872452f, 0.03760603070259094f, 0.016560440883040428f, 0.007292664609849453f, 0.0032114461064338684f,
    0.0014142135623842478f, 0.0006227724370546639f, 0.00027424818836152554f, 0.00012076973507646471f, 5.3182957344688475e-05f, 2.34199997066753e-05f, 1.0313385246263351e-05f, 4.541670477919979e-06f};
__device__ __forceinline__ void rope_entry(float* rope, int idx) {
    const int pos = idx >> 4, f = idx & 15;
    const float inv = ROPE_INV[f];
    const float ang = (float)pos * inv;
    const double x = (double)ang;
    const double q = rint(x * 0.63661977236758134308);
    double y = fma(-q, 1.57079632679489655800, x); y = fma(-q, 6.12323399573676603587e-17, y);
    const double y2 = y * y;
    double sp = -2.50521083854417187751e-08; sp = fma(sp, y2, 2.75573192239858906526e-06); sp = fma(sp, y2, -1.98412698412698412698e-04); sp = fma(sp, y2, 8.33333333333333333333e-03); sp = fma(sp, y2, -1.66666666666666666667e-01);
    const double sn = fma(y * y2, sp, y);
    double cp = 2.08767569878680989792e-09; cp = fma(cp, y2, -2.75573192239858906526e-07); cp = fma(cp, y2, 2.48015873015873015873e-05); cp = fma(cp, y2, -1.38888888888888888889e-03); cp = fma(cp, y2, 4.16666666666666666667e-02); cp = fma(cp, y2, -0.5);
    const double cn = fma(y2, cp, 1.0);
    const int qi = ((int)q) & 3;
    const double s = (qi == 0) ? sn : (qi == 1) ? cn : (qi == 2) ? -sn : -cn;
    const double c = (qi == 0) ? cn : (qi == 1) ? -sn : (qi == 2) ? -cn : sn;
    rope[2 * idx] = (float)c; rope[2 * idx + 1] = (float)s;
}
struct In { const float *x, *c, *w_ada, *b_ada, *g_ffn1, *w1_gate, *w1_up, *w1_down, *g_mix, *w_qkv, *qn_na, *kn_na, *qn_dil, *kn_dil, *rpb_na, *g_out_na, *g_out_dil, *w_o, *g_ffn2, *w2_gate, *w2_up, *w2_down; };
struct TrD { const float* W; bf16_t* WT; int K, N, mode, blk, item; };
__device__ __forceinline__ TrD tr_desc(const In& I, unsigned char* ws, int list, int it) {
    constexpr int NG = 5632; TrD d; d.blk = 1; d.mode = 0; d.K = D_; d.N = FF_; d.item = it; d.W = I.w1_gate; d.WT = (bf16_t*)(ws + WS_WGU1);
    if (list == 0) {
        if (it < NG) { d.mode = 1; }
        else if (it < 2 * NG) { d.W = I.w1_up; d.mode = 2; d.item = it - NG; }
        else if (it < 2 * NG + 2048) { d.W = I.w_o; d.WT = (bf16_t*)(ws + WS_WO); d.N = D_; d.item = it - 2 * NG; }
        else if (it < 3 * NG + 2048) { d.W = I.w2_gate; d.WT = (bf16_t*)(ws + WS_WGU2); d.mode = 1; d.item = it - 2 * NG - 2048; }
        else { d.W = I.w2_up; d.WT = (bf16_t*)(ws + WS_WGU2); d.mode = 2; d.item = it - 3 * NG - 2048; }
    } else if (list == 1) {
        if (it < NG) { d.W = I.w1_down; d.WT = (bf16_t*)(ws + WS_WD1); d.K = FF_; d.N = D_; d.blk = 1; }
        else { d.W = I.w_qkv; d.WT = (bf16_t*)(ws + WS_WQKV); d.N = 3 * D_; d.mode = 3; d.item = it - NG; }
    } else { d.W = I.w2_down; d.WT = (bf16_t*)(ws + WS_WD2); d.K = FF_; d.N = D_; d.blk = 1; }
    return d;
}
__device__ __forceinline__ void tr_load(const TrD& d, f32x4 (&v)[8], int lane) {
    const int nblk = d.N / 32, kb = d.item / nblk, nb = d.item - kb * nblk, k0 = 64 * kb, n0 = 32 * nb, kl = lane & 7, nl = lane >> 3;
    const float* p = d.W + (size_t)(k0 + 8 * kl) * d.N + n0 + 4 * nl;
#pragma unroll
    for (int e = 0; e < 8; ++e) v[e] = __builtin_nontemporal_load((const f32x4*)(p + (size_t)e * d.N));
}
__device__ __forceinline__ void tr_store(const TrD& d, const f32x4 (&v)[8], int lane) {
    const int nblk = d.N / 32, kb = d.item / nblk, nb = d.item - kb * nblk, k0 = 64 * kb, n0 = 32 * nb, kl = lane & 7, nl = lane >> 3, K = d.K;
    int rb = n0; bool perm = false;
    if (d.mode == 1) rb = ((n0 >> 7) << 8) + (n0 & 127); else if (d.mode == 2) rb = ((n0 >> 7) << 8) + 128 + (n0 & 127); else if (d.mode == 3) perm = (n0 < 4096) && ((n0 & 127) == 0);
#pragma unroll
    for (int i = 0; i < 4; ++i) { const int n = 4 * nl + i, dr = rb + (perm ? pos_of(n) : n);
        u32x4 o; o.x = cvtpk_s(v[0][i], v[1][i]); o.y = cvtpk_s(v[2][i], v[3][i]); o.z = cvtpk_s(v[4][i], v[5][i]); o.w = cvtpk_s(v[6][i], v[7][i]);
        const size_t di = d.blk ? ((((size_t)(dr >> 8) * (K >> 6) + (k0 >> 6)) * 256 + (dr & 255)) * 64 + 8 * kl) : ((size_t)dr * K + k0 + 8 * kl);
        *(u32x4*)(d.WT + di) = o; }
}
__device__ __forceinline__ void tr_run(const In& I, unsigned char* ws, int list, int it0, int step, int end, int lane) {
    int it = it0;
    for (; it + step < end; it += 2 * step) { const TrD a = tr_desc(I, ws, list, it), b = tr_desc(I, ws, list, it + step); f32x4 va[8], vb[8];
        tr_load(a, va, lane); tr_load(b, vb, lane); tr_store(a, va, lane); tr_store(b, vb, lane); }
    if (it < end) { const TrD a = tr_desc(I, ws, list, it); f32x4 va[8]; tr_load(a, va, lane); tr_store(a, va, lane); }
}
constexpr int TR_N0 = 4 * 5632 + 2048, TR_N1 = 5632 + 6144, TR_N2 = 5632;
__device__ __forceinline__ void p0_prologue(const In& I, unsigned char* ws, LAS unsigned char* lds, int gw, int NGW, int wave, int lane, bool do_mod) {
    LAS float* scr = (LAS float*)(lds + wave * 16384);
    float* mod = (float*)(ws + WS_MOD);
    if (do_mod) for (int it = gw; it < 64 * 16; it += NGW) mod_item(I.c, I.w_ada, I.b_ada, mod, it, lane, 0, 64);
    if (NGW == 2048) {
        tr_run(I, ws, 0, gw, 2048, 7 * 2048, lane);
        if (gw >= 1024) tr_run(I, ws, 0, 7 * 2048 + (gw - 1024), 1024, TR_N0, lane);
    } else tr_run(I, ws, 0, gw, NGW, TR_N0, lane);
    float* rope = (float*)(ws + WS_ROPE);
    for (int idx = gw * 64 + lane; idx < SEQ_ * 16; idx += NGW * 64) rope_entry(rope, idx);
    if (gw == 0) { float* gains = (float*)(ws + WS_GAIN); gains[lane] = I.qn_na[lane]; gains[64 + lane] = I.qn_na[64 + lane]; gains[128 + lane] = I.qn_dil[lane]; gains[192 + lane] = I.qn_dil[64 + lane];
        gains[256 + lane] = I.kn_na[lane]; gains[320 + lane] = I.kn_na[64 + lane]; gains[384 + lane] = I.kn_dil[lane]; gains[448 + lane] = I.kn_dil[64 + lane]; }
}
__device__ __forceinline__ void tail_convert(const In& I, unsigned char* ws, LAS unsigned char* lds, int G, int wave, int lane, int list, int nitems) {
    const int nwg = (M_ / 256) * (2 * FF_ / 256), rounds = (nwg + G - 1) / G, busy = nwg - (rounds - 1) * G;
    int nidle = G - busy, my = (int)blockIdx.x - busy;
    if (nidle <= 0) { nidle = G; my = (int)blockIdx.x; }
    if (my < 0) return;
    if (list == 2) for (int it = my * NWAVES + wave; it < 8 * 16; it += nidle * NWAVES) mod_item(I.c, I.w_ada, I.b_ada, (float*)(ws + WS_MOD), it, lane, 64, 8);
    tr_run(I, ws, list, my * NWAVES + wave, nidle * NWAVES, nitems, lane);
}

__device__ __forceinline__ void norm_mod_rows(const float* src, const float* __restrict__ g, const float* mod, int sh_idx, int sc_idx, bf16_t* A, int gw, int NGW, int lane) {
    for (int row = gw; row < M_; row += NGW) {
        const int b = row >> 12;
        const f32x4* xr = (const f32x4*)(src + (size_t)row * D_) + lane;
        f32x4 v[8]; float ss = 0.f;
#pragma unroll
        for (int j = 0; j < 8; ++j) { v[j] = __builtin_nontemporal_load(xr + 64 * j); ss += (v[j][0] * v[j][0] + v[j][1] * v[j][1]) + (v[j][2] * v[j][2] + v[j][3] * v[j][3]); }
        const float r = __builtin_amdgcn_rsqf(wave_sum(ss) * (1.f / D_) + EPS_);
        const float* sh = mod + (size_t)b * NMOD_ + sh_idx * D_; const float* sc = mod + (size_t)b * NMOD_ + sc_idx * D_;
        u32x2* o = (u32x2*)(A + (size_t)row * D_) + lane;
#pragma unroll
        for (int j = 0; j < 8; ++j) { const int k = 4 * lane + 256 * j; const f32x4 gg = *(const f32x4*)(g + k), s1 = *(const f32x4*)(sc + k), s0 = *(const f32x4*)(sh + k);
            const f32x4 y = v[j] * r * gg * (s1 + 1.0f) + s0; u32x2 w; w.x = cvtpk_s(y[0], y[1]); w.y = cvtpk_s(y[2], y[3]); o[64 * j] = w; }
    }
}

__device__ __forceinline__ void norm_mod_rows_bf(const bf16_t* src, const float* __restrict__ g, const float* mod, int sh_idx, int sc_idx, bf16_t* A, int gw, int NGW, int lane) {
    for (int row = gw; row < M_; row += NGW) {
        const int b = row >> 12;
        const u32x4* xr = (const u32x4*)(src + (size_t)row * D_) + lane;
        f32x4 v[4][2]; float ss = 0.f;
#pragma unroll
        for (int j = 0; j < 4; ++j) { const u32x4 w = __builtin_nontemporal_load(xr + 64 * j); { const pg8::f32x2e_t u0 = pg8::up_h16(w.x), u1 = pg8::up_h16(w.y), u2 = pg8::up_h16(w.z), u3 = pg8::up_h16(w.w); v[j][0] = (f32x4){u0.x, u0.y, u1.x, u1.y}; v[j][1] = (f32x4){u2.x, u2.y, u3.x, u3.y}; }
#pragma unroll
            for (int e = 0; e < 2; ++e) ss += (v[j][e][0] * v[j][e][0] + v[j][e][1] * v[j][e][1]) + (v[j][e][2] * v[j][e][2] + v[j][e][3] * v[j][e][3]); }
        const float r = __builtin_amdgcn_rsqf(wave_sum(ss) * (1.f / D_) + EPS_);
        const float* sh = mod + (size_t)b * NMOD_ + sh_idx * D_; const float* sc = mod + (size_t)b * NMOD_ + sc_idx * D_;
        u32x4* o = (u32x4*)(A + (size_t)row * D_) + lane;
#pragma unroll
        for (int j = 0; j < 4; ++j) { const int k = 8 * lane + 512 * j; f32x4 y[2];
#pragma unroll
            for (int e = 0; e < 2; ++e) { const f32x4 gg = *(const f32x4*)(g + k + 4 * e), s1 = *(const f32x4*)(sc + k + 4 * e), s0 = *(const f32x4*)(sh + k + 4 * e); y[e] = v[j][e] * r * gg * (s1 + 1.0f) + s0; }
            u32x4 w; w.x = cvtpk_s(y[0][0], y[0][1]); w.y = cvtpk_s(y[0][2], y[0][3]); w.z = cvtpk_s(y[1][0], y[1][1]); w.w = cvtpk_s(y[1][2], y[1][3]); o[64 * j] = w; }
    }
}

constexpr int KROW = 272;
constexpr int KB_OFF = 0, VB_OFF = 256 * KROW, RK_OFF = 2 * 256 * KROW;
typedef short v4i16_t __attribute__((ext_vector_type(4)));
__device__ __forceinline__ s16x4 vtr(LAS const unsigned char* p) { return __builtin_bit_cast(s16x4, __builtin_amdgcn_ds_read_tr16_b64_v4i16((LAS v4i16_t*)p)); }
#define MFMA16(a, b, c) __builtin_amdgcn_mfma_f32_16x16x32_bf16((a), (b), (c), 0, 0, 0)
struct AttnT { const bf16_t *Q, *K, *V; const float* ssq; const float* rpb; bf16_t* ONA; bf16_t* ODIL; float* LSE; };

constexpr int BIAS_OFF = RK_OFF + 1024;
struct UD { int na, b, r, hp, rs, h, p, dd, rho, sb, nsb; };
__device__ __forceinline__ UD decode_unit(int u) {
    UD d; d.na = u < 512; d.r = 0; d.hp = 0; d.rs = 0; d.h = 0; d.p = 0; d.dd = 1; d.rho = 0; d.sb = 0; d.nsb = 1;
    if (d.na) { d.hp = u & 3; d.r = (u >> 2) & 63; d.b = u >> 8; d.rs = min(max(d.r - 4, 0), 56); }
    else { const int v = u - 512, blk = v & 31; d.p = (v >> 5) % 3; d.h = (v / 96) & 7; d.b = v / 768; const int sh2 = 2 * d.p; d.dd = 1 << sh2; d.rho = blk & (d.dd - 1); d.sb = blk >> sh2; d.nsb = 32 >> sh2; }
    return d;
}
struct CD { int b, tbase, smask, dd, hbase, hsel; };
__device__ __forceinline__ CD chunk_desc(const UD& d, int ck) {
    CD c; c.b = d.b; c.dd = d.dd;
    c.tbase = d.na ? (d.rs + 2 * ck) * 64 : d.rho + (128 * d.sb - 64) * d.dd;
    c.smask = d.na ? 127 : 255; c.hbase = d.na ? 2 * d.hp : 8 + d.h; c.hsel = d.na ? 1 : 0;
    return c;
}
struct Pre { u32x4 k[8]; f32x4 ks4; bf16x8 qf[4]; f32x4 qs4; float bias; };
__device__ __forceinline__ void prefetch_chunk(Pre& P, const AttnT& T, const CD& cd, int tid) {
    const unsigned char* Kg = (const unsigned char*)T.K;
    const int piece = tid & 15;
#pragma unroll
    for (int i = 0; i < 8; ++i) { const int slot = (tid >> 4) + 32 * i;
        const int token = min(max(cd.tbase + (slot & cd.smask) * cd.dd, 0), SEQ_ - 1), khead = cd.hbase + ((slot >> 7) & cd.hsel);
        const unsigned goff = (unsigned)(((cd.b * SEQ_ + token) * D_ + khead * 128) * 2 + piece * 16);
        P.k[i] = *(const u32x4*)(Kg + goff); }
    { const int slot = tid & 255; const int token = min(max(cd.tbase + (slot & cd.smask) * cd.dd, 0), SEQ_ - 1), khead = cd.hbase + ((slot >> 7) & cd.hsel);
        const float* sp = T.ssq + (unsigned)((16 + khead) * M_ + cd.b * SEQ_ + token); P.ks4 = (f32x4){sp[0], sp[32 * M_], sp[64 * M_], sp[96 * M_]}; }
}
__device__ __forceinline__ void load_v(u32x4 (&v)[8], const AttnT& T, const CD& cd, int tid) {
    const unsigned char* Vg = (const unsigned char*)T.V; const int piece = tid & 15;
#pragma unroll
    for (int i = 0; i < 8; ++i) { const int slot = (tid >> 4) + 32 * i;
        const int token = min(max(cd.tbase + (slot & cd.smask) * cd.dd, 0), SEQ_ - 1), khead = cd.hbase + ((slot >> 7) & cd.hsel);
        v[i] = *(const u32x4*)(Vg + (unsigned)(((cd.b * SEQ_ + token) * D_ + khead * 128) * 2 + piece * 16)); }
}
__device__ __forceinline__ void unit_query(const UD& d, int w, int c, int& jq, int& tq, int& head) {
    jq = 16 * (w & (d.na ? 3 : 7)) + c; tq = (d.na ? d.r * 64 : d.rho + 128 * d.sb * d.dd) + jq * d.dd; head = d.na ? 2 * d.hp + (w >> 2) : 8 + d.h;
}
__device__ __forceinline__ void prefetch_q(Pre& P, const AttnT& T, const UD& d, int w, int lane, int tid) {
    int jq, tq, head; unit_query(d, w, lane & 15, jq, tq, head);
    const unsigned rowQ = (unsigned)(d.b * SEQ_ + tq);
    const unsigned char* qp = (const unsigned char*)T.Q + (unsigned)((rowQ * D_ + head * 128 + 8 * (lane >> 4)) * 2);
#pragma unroll
    for (int ks = 0; ks < 4; ++ks) P.qf[ks] = *(const bf16x8*)(qp + 64 * ks);
    { const float* sp = T.ssq + (unsigned)(head * M_) + rowQ; P.qs4 = (f32x4){sp[0], sp[32 * M_], sp[64 * M_], sp[96 * M_]}; }
    { const int hh2 = tid >> 8, i8 = (tid >> 5) & 7, co = min(tid & 31, 30);
      P.bias = T.rpb[((2 * d.hp + hh2) * 15 + (d.rs + i8 - d.r + 7)) * 31 + co] * 1.4426950408889634f; }
}
template <bool NA>
__device__ __forceinline__ void attn_unit(LAS unsigned char* lds, const AttnT& T, const UD& d, const UD& nxt, bool has_next, Pre& P) {
    constexpr int NT = NA ? 4 : 10, NCH = NA ? 4 : 1;
    const int tid = threadIdx.x, lane = tid & 63, w = __builtin_amdgcn_readfirstlane(tid >> 6), c = lane & 15, g = lane >> 4;
    const int hh = w >> 2, qg = w & 3;
    int jq, tq, head; unit_query(d, w, c, jq, tq, head);
    const size_t rowQ = (size_t)d.b * SEQ_ + tq;
    if (NA) prefetch_q(P, T, d, w, lane, tid);
    bf16x8 qf[4];
#pragma unroll
    for (int ks = 0; ks < 4; ++ks) qf[ks] = P.qf[ks];
    const float rq = __builtin_amdgcn_rsqf(((P.qs4[0] + P.qs4[1]) + (P.qs4[2] + P.qs4[3])) * (1.f / 128.f) + EPS_) * (0.08838834764831845f * 1.4426950408889634f);
    const float biasv = P.bias;
    const int W0 = NA ? (qg == 0 ? 0 : qg == 1 ? 8 : qg == 2 ? 24 : 32) : 0;
    const int cs = min(max(jq - 8, 0), 48);
    const int lo_s = (!NA && d.sb == 0) ? 64 : 0, hi_s = (!NA && d.sb == d.nsb - 1) ? 192 : 256;
    f32x4 O[8];
#pragma unroll
    for (int dt = 0; dt < 8; ++dt) O[dt] = (f32x4){0.f, 0.f, 0.f, 0.f};
    float m_run = -1e30f, l_run = 0.f;
    LAS float* rk = (LAS float*)(lds + RK_OFF);
#pragma unroll 1
    for (int ck = 0; ck < NCH; ++ck) {
        u32x4 vreg[8]; load_v(vreg, T, chunk_desc(d, ck), tid);
#pragma unroll
        for (int i = 0; i < 8; ++i) { const int slot = (tid >> 4) + 32 * i, piece = tid & 15;
            *(LAS u32x4*)(lds + KB_OFF + slot * KROW + piece * 16) = P.k[i]; }
        if (tid < 256) rk[tid] = __builtin_amdgcn_rsqf(((P.ks4[0] + P.ks4[1]) + (P.ks4[2] + P.ks4[3])) * (1.f / 128.f) + EPS_);
        if (NA && ck == 0) ((LAS float*)(lds + BIAS_OFF))[tid] = biasv;
        __syncthreads();
        { const CD cdn = (ck + 1 < NCH) ? chunk_desc(d, ck + 1) : chunk_desc(nxt, 0); if (ck + 1 < NCH || has_next) prefetch_chunk(P, T, cdn, tid); }
        f32x4 s[NT]; float mx = -1e30f;
#pragma unroll
        for (int t = 0; t < NT; ++t) {
            const int tb = NA ? hh * 128 + (t >> 1) * 64 + W0 + 16 * (t & 1) : 16 * w + 16 * t;
            if (!NA && t == 9) { s[t] = (f32x4){-1e30f, -1e30f, -1e30f, -1e30f}; continue; }
            f32x4 acc = {0.f, 0.f, 0.f, 0.f};
#pragma unroll
            for (int ks = 0; ks < 4; ++ks) { const bf16x8 a = *(const LAS bf16x8*)(lds + KB_OFF + (tb + c) * KROW + (32 * ks + 8 * g) * 2); acc = MFMA16(a, qf[ks], acc); }
            const f32x4 rk4 = *(const LAS f32x4*)(lds + RK_OFF + (tb + 4 * g) * 4);
#pragma unroll
            for (int i = 0; i < 4; ++i) {
                float v = acc[i] * rq * rk4[i]; bool valid;
                if (NA) { const int kc = W0 + 16 * (t & 1) + 4 * g + i; valid = (kc >= cs) && (kc < cs + 16);
                    const int co = min(max(kc - jq + 15, 0), 30);
                    v += *(const LAS float*)(lds + BIAS_OFF + ((hh * 8 + 2 * ck + (t >> 1)) * 32 + co) * 4); }
                else { const int slot = tb + 4 * g + i; valid = (slot >= lo_s) && (slot < hi_s);
                    if (t == 0) valid = valid && (4 * g + i >= c);
                    if (t == 8) valid = valid && (4 * g + i <= c); }
                v = valid ? v : -1e30f; acc[i] = v; mx = fmaxf(mx, v);
            }
            s[t] = acc;
        }
        if (!NA && ck + 1 >= NCH && has_next) prefetch_q(P, T, nxt, w, lane, tid);
        mx = fmaxf(mx, __shfl_xor(mx, 16)); mx = fmaxf(mx, __shfl_xor(mx, 32));
        const float m_new = fmaxf(m_run, mx), alpha = __builtin_amdgcn_exp2f(m_run - m_new);
        float ls = 0.f;
#pragma unroll
        for (int t = 0; t < NT; ++t)
#pragma unroll
            for (int i = 0; i < 4; ++i) { const float pv = __builtin_amdgcn_exp2f(s[t][i] - m_new); s[t][i] = pv; ls += pv; }
        ls += __shfl_xor(ls, 16); ls += __shfl_xor(ls, 32);
        l_run = l_run * alpha + ls; m_run = m_new;
        if (NA) {
#pragma unroll
            for (int dt = 0; dt < 8; ++dt) O[dt] *= alpha;
        }
#pragma unroll
        for (int i = 0; i < 8; ++i) { const int slot = (tid >> 4) + 32 * i, piece = tid & 15; *(LAS u32x4*)(lds + VB_OFF + slot * KROW + piece * 16) = vreg[i]; }
        __syncthreads();
#pragma unroll
        for (int u = 0; u < NT / 2; ++u) {
            const int t0 = 2 * u, t1 = 2 * u + 1;
            int tb0 = NA ? hh * 128 + (t0 >> 1) * 64 + W0 + 16 * (t0 & 1) : 16 * w + 16 * t0;
            int tb1 = NA ? hh * 128 + (t1 >> 1) * 64 + W0 + 16 * (t1 & 1) : 16 * w + 16 * t1;
            if (!NA) { tb0 = min(tb0, 240); tb1 = min(tb1, 240); }
            u32x4 pw; pw.x = cvtpk_s(s[t0][0], s[t0][1]); pw.y = cvtpk_s(s[t0][2], s[t0][3]); pw.z = cvtpk_s(s[t1][0], s[t1][1]); pw.w = cvtpk_s(s[t1][2], s[t1][3]);
            const bf16x8 pb = __builtin_bit_cast(bf16x8, pw);
            LAS const unsigned char* v0 = lds + VB_OFF + (tb0 + 4 * g + (c >> 2)) * KROW + 8 * (c & 3);
            LAS const unsigned char* v1 = lds + VB_OFF + (tb1 + 4 * g + (c >> 2)) * KROW + 8 * (c & 3);
#pragma unroll
            for (int dt = 0; dt < 8; ++dt) { const s16x4 lo = vtr(v0 + 32 * dt), hi = vtr(v1 + 32 * dt);
                const bf16x8 a = {lo[0], lo[1], lo[2], lo[3], hi[0], hi[1], hi[2], hi[3]}; O[dt] = MFMA16(a, pb, O[dt]); }
        }
    }
    const float inv = __builtin_amdgcn_rcpf(l_run);
    bf16_t* ob = NA ? T.ONA + rowQ * 1024 + head * 128 : T.ODIL + ((size_t)d.p * M_ + rowQ) * 1024 + d.h * 128;
#pragma unroll
    for (int e = 0; e < 4; ++e) {
        const unsigned a0 = cvtpk_s(O[2 * e][0] * inv, O[2 * e][1] * inv), a1 = cvtpk_s(O[2 * e][2] * inv, O[2 * e][3] * inv);
        const unsigned b0 = cvtpk_s(O[2 * e + 1][0] * inv, O[2 * e + 1][1] * inv), b1 = cvtpk_s(O[2 * e + 1][2] * inv, O[2 * e + 1][3] * inv);
        const bool odd = g & 1;
        const unsigned r0 = __shfl_xor(odd ? a0 : b0, 16), r1 = __shfl_xor(odd ? a1 : b1, 16);
        u32x4 wv; if (odd) { wv.x = r0; wv.y = r1; wv.z = b0; wv.w = b1; } else { wv.x = a0; wv.y = a1; wv.z = r0; wv.w = r1; }
        *(u32x4*)(ob + 32 * e + (odd ? 16 + 4 * (g - 1) : 4 * g)) = wv; }
    if (!NA && g == 0) T.LSE[((size_t)d.p * M_ + rowQ) * 8 + d.h] = (m_run + __builtin_amdgcn_logf(l_run)) * 0.6931471805599453f;
}
template <bool NA>
__device__ __forceinline__ int unit_of(int i, int G) {
    const int bx = blockIdx.x;
    if (G != 256) return NA ? bx + i * G : bx + i * G;
    const int x = bx & 7, j = bx >> 3;
    if (NA) return ((x >> 2) << 8) | ((2 * j + i) << 2) | (x & 3);
    const int bh = 2 * x + i / 3, v = j * 3 + (i % 3);
    return bh * 96 + v;
}
template <bool NA>
__device__ __forceinline__ void attn_loop(LAS unsigned char* lds, const AttnT& T, int G) {
    const int nun = NA ? 512 : 1536, ubase = NA ? 0 : 512;
    const int cnt = (G == 256) ? (NA ? 2 : 6) : (nun - (int)blockIdx.x + G - 1) / G;
    if (cnt <= 0) return;
    const int tid = threadIdx.x, lane = tid & 63, w = __builtin_amdgcn_readfirstlane(tid >> 6);
    UD cur = decode_unit(ubase + unit_of<NA>(0, G));
    Pre P; prefetch_chunk(P, T, chunk_desc(cur, 0), tid); if (!NA) prefetch_q(P, T, cur, w, lane, tid);
#pragma unroll 1
    for (int i = 0; i < cnt; ++i) {
        const bool has_next = i + 1 < cnt; const UD nxt = decode_unit(ubase + unit_of<NA>(has_next ? i + 1 : i, G));
        attn_unit<NA>(lds, T, cur, nxt, has_next, P);
        cur = nxt;
    }
    __syncthreads();
}
__device__ __forceinline__ void attn_phase(LAS unsigned char* lds, const AttnT& T, int G) {
    attn_loop<true>(lds, T, G);
    attn_loop<false>(lds, T, G);
}
__device__ __forceinline__ void combine_rows(const bf16_t* ONA, const bf16_t* ODIL, const float* LSE, const float* __restrict__ g_na, const float* __restrict__ g_dil, bf16_t* A, int gw, int NGW, int lane) {
    for (int row = gw; row < M_; row += NGW) {
        float va[2][8], vd[2][8]; float sa = 0.f, sd = 0.f;
#pragma unroll
        for (int j = 0; j < 2; ++j) {
            const int k = 8 * lane + 512 * j;
            const u32x4 x = __builtin_nontemporal_load((const u32x4*)(ONA + (size_t)row * 1024 + k));
            va[j][0] = bflo(x.x); va[j][1] = bfhi(x.x); va[j][2] = bflo(x.y); va[j][3] = bfhi(x.y); va[j][4] = bflo(x.z); va[j][5] = bfhi(x.z); va[j][6] = bflo(x.w); va[j][7] = bfhi(x.w);
            const int hd = k >> 7;
            const float l0 = LSE[((size_t)0 * M_ + row) * 8 + hd], l1 = LSE[((size_t)1 * M_ + row) * 8 + hd], l2 = LSE[((size_t)2 * M_ + row) * 8 + hd];
            const float mm = fmaxf(l0, fmaxf(l1, l2)); float w0 = __expf(l0 - mm), w1 = __expf(l1 - mm), w2 = __expf(l2 - mm); const float wi = 1.f / (w0 + w1 + w2); w0 *= wi; w1 *= wi; w2 *= wi;
            const u32x4 y0 = __builtin_nontemporal_load((const u32x4*)(ODIL + ((size_t)0 * M_ + row) * 1024 + k)), y1 = __builtin_nontemporal_load((const u32x4*)(ODIL + ((size_t)1 * M_ + row) * 1024 + k)), y2 = __builtin_nontemporal_load((const u32x4*)(ODIL + ((size_t)2 * M_ + row) * 1024 + k));
            vd[j][0] = w0 * bflo(y0.x) + w1 * bflo(y1.x) + w2 * bflo(y2.x); vd[j][1] = w0 * bfhi(y0.x) + w1 * bfhi(y1.x) + w2 * bfhi(y2.x);
            vd[j][2] = w0 * bflo(y0.y) + w1 * bflo(y1.y) + w2 * bflo(y2.y); vd[j][3] = w0 * bfhi(y0.y) + w1 * bfhi(y1.y) + w2 * bfhi(y2.y);
            vd[j][4] = w0 * bflo(y0.z) + w1 * bflo(y1.z) + w2 * bflo(y2.z); vd[j][5] = w0 * bfhi(y0.z) + w1 * bfhi(y1.z) + w2 * bfhi(y2.z);
            vd[j][6] = w0 * bflo(y0.w) + w1 * bflo(y1.w) + w2 * bflo(y2.w); vd[j][7] = w0 * bfhi(y0.w) + w1 * bfhi(y1.w) + w2 * bfhi(y2.w);
#pragma unroll
            for (int e = 0; e < 8; ++e) { sa += va[j][e] * va[j][e]; sd += vd[j][e] * vd[j][e]; }
        }
        const float ra = __builtin_amdgcn_rsqf(wave_sum(sa) * (1.f / 1024.f) + EPS_), rd = __builtin_amdgcn_rsqf(wave_sum(sd) * (1.f / 1024.f) + EPS_);
#pragma unroll
        for (int j = 0; j < 2; ++j) {
            const int k = 8 * lane + 512 * j;
            const f32x4 ga0 = *(const f32x4*)(g_na + k), ga1 = *(const f32x4*)(g_na + k + 4), gd0 = *(const f32x4*)(g_dil + k), gd1 = *(const f32x4*)(g_dil + k + 4);
            u32x4 oa, od;
            oa.x = cvtpk_s(va[j][0] * ra * ga0[0], va[j][1] * ra * ga0[1]); oa.y = cvtpk_s(va[j][2] * ra * ga0[2], va[j][3] * ra * ga0[3]);
            oa.z = cvtpk_s(va[j][4] * ra * ga1[0], va[j][5] * ra * ga1[1]); oa.w = cvtpk_s(va[j][6] * ra * ga1[2], va[j][7] * ra * ga1[3]);
            od.x = cvtpk_s(vd[j][0] * rd * gd0[0], vd[j][1] * rd * gd0[1]); od.y = cvtpk_s(vd[j][2] * rd * gd0[2], vd[j][3] * rd * gd0[3]);
            od.z = cvtpk_s(vd[j][4] * rd * gd1[0], vd[j][5] * rd * gd1[1]); od.w = cvtpk_s(vd[j][6] * rd * gd1[2], vd[j][7] * rd * gd1[3]);
            *(u32x4*)(A + (size_t)row * D_ + k) = oa; *(u32x4*)(A + (size_t)row * D_ + 1024 + k) = od;
        }
    }
}

#define XB_TMO      128
#define XB_XCNT(j)  (256  + 64 * (j))
#define XB_XSUB(j)  (1280 + 64 * (j))
#define XB_XGEN(j)  (2304 + 64 * (j))
#define XB_TOP      3328
#define XB_TOPGEN   3392
#define XCD_BAR_WORDS 3456
#define XB_SPIN_CAP (1u << 18)

__device__ __forceinline__ unsigned xb_ld(unsigned* p)              { return __hip_atomic_load(p, __ATOMIC_RELAXED, __HIP_MEMORY_SCOPE_AGENT); }
__device__ __forceinline__ unsigned xb_add(unsigned* p, unsigned v) { return __hip_atomic_fetch_add(p, v, __ATOMIC_RELAXED, __HIP_MEMORY_SCOPE_AGENT); }
__device__ __forceinline__ unsigned xb_xcc_id() { return (unsigned)__builtin_amdgcn_s_getreg((3 << 11) | 20) & 0xFu; }
#define XB_SPIN(cond, bar) do { unsigned _sp = 0; while (cond) { __builtin_amdgcn_s_sleep(1); \
    if ((++_sp & 255u) == 0u) { if (xb_ld(&(bar)[XB_TMO])) break; if (_sp > XB_SPIN_CAP) { atomicAdd(&(bar)[XB_TMO], 1u); break; } } } } while (0)

struct XcdBarrier {
    unsigned* bar; unsigned x;
    volatile LAS unsigned* st;
};

__device__ __forceinline__ XcdBarrier xcd_barrier_post(unsigned* bar, volatile LAS unsigned* st) {
    XcdBarrier b; b.bar = bar; b.x = xb_xcc_id(); b.st = st;
    if (threadIdx.x == 0) (void)xb_add(&bar[XB_XCNT(b.x)], 1u);
    return b;
}
__device__ __forceinline__ void xcd_barrier_complete(unsigned* bar, unsigned x, unsigned& nloc, unsigned& nx) {
    const unsigned G = gridDim.x * gridDim.y * gridDim.z;
    unsigned sum, cnt, mine, sp = 0u;
    for (;;) {
        sum = 0u; cnt = 0u; mine = 0u;
#pragma unroll
        for (unsigned j = 0; j < 16; ++j) { const unsigned c = xb_ld(&bar[XB_XCNT(j)]); sum += c; cnt += (c > 0u) ? 1u : 0u; mine = (j == x) ? c : mine; }
        if (sum == G) break;
        __builtin_amdgcn_s_sleep(1);
        if ((++sp & 255u) == 0u) { if (xb_ld(&bar[XB_TMO])) break; if (sp > XB_SPIN_CAP) { atomicAdd(&bar[XB_TMO], 1u); break; } }
    }
    nloc = mine > 0u ? mine : 1u; nx = cnt > 0u ? cnt : 1u;
}

__device__ __forceinline__ void xcd_barrier(const XcdBarrier& b) {
    asm volatile("s_waitcnt vmcnt(0)" ::: "memory");
    __syncthreads();
    if (threadIdx.x == 0) {
        unsigned* bar = b.bar;
        __builtin_amdgcn_s_waitcnt(0);
        unsigned nloc = b.st[0], nx = b.st[1];
        if (nloc == 0u) { xcd_barrier_complete(bar, b.x, nloc, nx); b.st[0] = nloc; b.st[1] = nx; }
        const unsigned old = xb_add(&bar[XB_XSUB(b.x)], 1u);
        const unsigned gen = old / nloc;
        if (old + 1u == (gen + 1u) * nloc) {
            __builtin_amdgcn_fence(__ATOMIC_RELEASE, "agent");
            asm volatile("s_waitcnt vmcnt(0)" ::: "memory");
            const unsigned og = xb_add(&bar[XB_TOP], 1u);
            const unsigned tg = og / nx;
            if (og + 1u == (tg + 1u) * nx) xb_add(&bar[XB_TOPGEN], 1u);
            else XB_SPIN(xb_ld(&bar[XB_TOPGEN]) == tg, bar);
            __builtin_amdgcn_fence(__ATOMIC_ACQUIRE, "agent");
            xb_add(&bar[XB_XGEN(b.x)], 1u);
            asm volatile("s_waitcnt vmcnt(0)" ::: "memory");
        } else {
            XB_SPIN(xb_ld(&bar[XB_XGEN(b.x)]) == gen, bar);
            __builtin_amdgcn_fence(__ATOMIC_ACQUIRE, "agent");
            asm volatile("s_waitcnt vmcnt(0)" ::: "memory");
        }
    }
    __syncthreads();
}

struct Args { In in; float* out; unsigned char* ws; int ph_lo, ph_hi; };
constexpr int NPHASE = 12;
__global__ void __launch_bounds__(NWAVES * 64, 2) fwd_kernel(Args a) {
    extern __shared__ __attribute__((aligned(16))) unsigned char lds_raw[];
    LAS unsigned char* lds = (LAS unsigned char*)lds_raw;
    const int tid = threadIdx.x, lane = tid & 63, wave = __builtin_amdgcn_readfirstlane(tid >> 6);
    const int G = gridDim.x, gw = blockIdx.x * NWAVES + wave, NGW = G * NWAVES;
    unsigned char* ws = a.ws; const In& I = a.in;
    float* mod = (float*)(ws + WS_MOD);
    bf16_t* A = (bf16_t*)(ws + WS_A); bf16_t* H = (bf16_t*)(ws + WS_H);
    const int lo = a.ph_lo, hi = a.ph_hi;
#define IN(k) (lo <= (k) && (k) < hi)
#if MK_MULTI
#define SEAM(k) do { } while (0)
#else
    volatile LAS unsigned* MISC = (volatile LAS unsigned*)(lds + MISC_OFF);
    if (tid < 16) MISC[tid] = 0u;
    __syncthreads();
    XcdBarrier xbar = xcd_barrier_post((unsigned*)(ws + WS_BAR), MISC);
#define SEAM(k) do { if (IN(k) && IN((k) + 1)) { xcd_barrier(xbar); } } while (0)
#endif
    if (IN(0)) { p0_prologue(I, ws, lds, gw, NGW, wave, lane, true); if (PROBE_DUP == 0) p0_prologue(I, ws, lds, gw, NGW, wave, lane, false); } SEAM(0);
    if (IN(1)) for (int rep_ = 0; rep_ < (PROBE_DUP == 1 ? 2 : 1); ++rep_) { norm_mod_rows(I.x, I.g_ffn1, mod, 0, 1, A, gw, NGW, lane); } SEAM(1);
    if (IN(2)) for (int rep_ = 0; rep_ < (PROBE_DUP == 2 ? 2 : 1); ++rep_) { pg8::Gemm g{A, (const bf16_t*)(ws + WS_WGU1), M_, 2 * FF_, D_}; pg8::StaticOrder S; S.init(M_, 2 * FF_, G, (int)blockIdx.x); pg8::EpiSwiGLU E{H};
        pg8::gemm_phase<pg8::EpiSwiGLU, pg8::StaticOrder, true, true, false, true>(lds, g, S, E); if (rep_ == 0) tail_convert(I, ws, lds, G, wave, lane, 1, TR_N1); } SEAM(2);
    if (IN(3)) for (int rep_ = 0; rep_ < (PROBE_DUP == 3 ? 2 : 1); ++rep_) { pg8::Gemm g{H, (const bf16_t*)(ws + WS_WD1), M_, D_, FF_}; pg8::StaticOrder S; S.init(M_, D_, G, (int)blockIdx.x, 4); pg8::EpiResid<false, true, 1> E{I.x, ws + WS_HB, mod + 2 * D_};
        pg8::gemm_phase<pg8::EpiResid<false, true, 1>, pg8::StaticOrder, true, true, true, true>(lds, g, S, E); } SEAM(3);
    if (IN(4)) { norm_mod_rows_bf((const bf16_t*)(ws + WS_HB), I.g_mix, mod, 3, 4, A, gw, NGW, lane); } SEAM(4);
    if (IN(5)) for (int rep_ = 0; rep_ < (PROBE_DUP == 5 ? 2 : 1); ++rep_) { pg8::Gemm g{A, (const bf16_t*)(ws + WS_WQKV), M_, 3 * D_, D_}; pg8::StaticOrder S; S.init(M_, 3 * D_, G, (int)blockIdx.x);
        pg8::EpiQKV E{(bf16_t*)(ws + WS_Q), (float*)(ws + WS_SSQ), (const float*)(ws + WS_GAIN), (const float*)(ws + WS_ROPE)};
        pg8::gemm_phase<pg8::EpiQKV, pg8::StaticOrder, true, true, false, true>(lds, g, S, E); } SEAM(5);
    if (IN(6)) for (int rep_ = 0; rep_ < (PROBE_DUP == 6 ? 2 : 1); ++rep_) { AttnT T{(const bf16_t*)(ws + WS_Q), (const bf16_t*)(ws + WS_K), (const bf16_t*)(ws + WS_V), (const float*)(ws + WS_SSQ), I.rpb_na, (bf16_t*)(ws + WS_ONA), (bf16_t*)(ws + WS_ODIL), (float*)(ws + WS_LSE)};
        attn_phase(lds, T, G); } SEAM(6);
    if (IN(7)) for (int rep_ = 0; rep_ < (PROBE_DUP == 7 ? 2 : 1); ++rep_) { combine_rows((const bf16_t*)(ws + WS_ONA), (const bf16_t*)(ws + WS_ODIL), (const float*)(ws + WS_LSE), I.g_out_na, I.g_out_dil, A, gw, NGW, lane); } SEAM(7);
    if (IN(8)) { pg8::Gemm g{A, (const bf16_t*)(ws + WS_WO), M_, D_, D_}; pg8::StaticOrder S; S.init(M_, D_, G, (int)blockIdx.x); pg8::EpiResid<true, true, 2> E{ws + WS_HB, ws + WS_HB, mod + 5 * D_};
        pg8::gemm_phase<pg8::EpiResid<true, true, 2>, pg8::StaticOrder, true, true, false, true>(lds, g, S, E); } SEAM(8);
    if (IN(9)) { norm_mod_rows_bf((const bf16_t*)(ws + WS_HB), I.g_ffn2, mod, 6, 7, A, gw, NGW, lane); } SEAM(9);
    if (IN(10)) { pg8::Gemm g{A, (const bf16_t*)(ws + WS_WGU2), M_, 2 * FF_, D_}; pg8::StaticOrder S; S.init(M_, 2 * FF_, G, (int)blockIdx.x); pg8::EpiSwiGLU E{H};
        pg8::gemm_phase<pg8::EpiSwiGLU, pg8::StaticOrder, true, true, false, true>(lds, g, S, E); tail_convert(I, ws, lds, G, wave, lane, 2, TR_N2); } SEAM(10);
    if (IN(11)) { pg8::Gemm g{H, (const bf16_t*)(ws + WS_WD2), M_, D_, FF_}; pg8::StaticOrder S; S.init(M_, D_, G, (int)blockIdx.x, 4); pg8::EpiResid<true, false, 1> E{ws + WS_HB, a.out, mod + 8 * D_};
        pg8::gemm_phase<pg8::EpiResid<true, false, 1>, pg8::StaticOrder, true, true, true, true>(lds, g, S, E); }
#undef IN
#undef SEAM
}

extern "C" void kernel_launch(void* const* d_in, const int* in_sizes, int n_in, void* d_out, int out_size, void* d_ws, size_t ws_size, hipStream_t stream) {
    static int grid = 0;
    if (grid == 0) {
        if (n_in != 22 || out_size != M_ * D_ || ws_size < WS_END) { fprintf(stderr, "kernel_launch: unexpected shapes (n_in %d out %d ws %zu)\n", n_in, out_size, ws_size); grid = -1; return; }
        int dev = 0, cus = 0, per_cu = 0;
        (void)hipGetDevice(&dev); (void)hipDeviceGetAttribute(&cus, hipDeviceAttributeMultiprocessorCount, dev);
        if (hipFuncSetAttribute((const void*)fwd_kernel, hipFuncAttributeMaxDynamicSharedMemorySize, LDS_BYTES) != hipSuccess) { fprintf(stderr, "kernel_launch: hipFuncSetAttribute failed\n"); grid = -1; return; }
        if (hipOccupancyMaxActiveBlocksPerMultiprocessor(&per_cu, (const void*)fwd_kernel, NWAVES * 64, LDS_BYTES) != hipSuccess || per_cu < 1) { fprintf(stderr, "kernel_launch: occupancy query failed (%d)\n", per_cu); (void)hipGetLastError(); per_cu = 1; }
        grid = cus * per_cu;
    }
    if (grid < 0) return;
    (void)hipMemsetAsync((char*)d_ws + WS_MOD, 0, WS_ZERO_BYTES, stream);
    Args a{};
    const float** ip = (const float**)&a.in;
    for (int i = 0; i < 22; ++i) ip[i] = (const float*)d_in[i];
    a.out = (float*)d_out; a.ws = (unsigned char*)d_ws;
#if MK_MULTI
    for (int ph = 0; ph < NPHASE; ++ph) { a.ph_lo = ph; a.ph_hi = ph + 1; hipLaunchKernelGGL(fwd_kernel, dim3(grid), dim3(NWAVES * 64), LDS_BYTES, stream, a); }
#else
    a.ph_lo = 0; a.ph_hi = NPHASE;
    void* args[] = {&a};
    hipError_t e = hipLaunchCooperativeKernel((const void*)fwd_kernel, dim3(grid), dim3(NWAVES * 64), args, LDS_BYTES, stream);
    if (e != hipSuccess) fprintf(stderr, "cooperative launch failed: %s (grid %d)\n", hipGetErrorString(e), grid);
#endif
}
```

```cpp
#include <hip/hip_runtime.h>
#include <hip/hip_cooperative_groups.h>
#include <cstdio>
#include <cstdint>
namespace cg = cooperative_groups;

#ifndef PROBE_DUP
#define PROBE_DUP -1
#endif
#ifndef MK_MULTI
#define MK_MULTI 0
#endif

namespace pg8 {
#define PG8_LAS __attribute__((address_space(3)))
typedef unsigned short bf16_t;
typedef short bf16x8 __attribute__((ext_vector_type(8)));
typedef float f32x4 __attribute__((ext_vector_type(4)));
typedef unsigned u32x4 __attribute__((ext_vector_type(4)));
constexpr int BM = 256, BK = 64, HALF = 128, HTB = HALF * BK * 2  , STAGE_BYTES = 8 * HTB, NXCD = 8, WGM = 8;

__host__ __device__ __forceinline__ int lds_byte(int r, int c) { const int st = (r >> 4) * 2 + (c >> 5), rr = r & 15, cc = c & 31, ob = rr * 64 + cc * 2; return st * 1024 + (ob ^ (((ob >> 9) & 1) << 5)); }
__host__ __device__ __forceinline__ void stage_rc(int b, int& R, int& C) { const int st = b / 1024, sb = b % 1024, swz = sb ^ (((sb >> 9) & 1) << 5); R = (st >> 1) * 16 + swz / 64; C = (st & 1) * 32 + (swz % 64) / 2; }
__host__ __device__ __forceinline__ int perm32(int rho) { const int n = rho >> 4, i = rho & 15; return 8 * (i >> 2) + 4 * n + (i & 3); }

struct Unit { int pm, pn; };
struct Gemm { const bf16_t* A; const bf16_t* Bt; int M, N, K; };

struct StaticOrder {
    int nM, nN, nwg, G, c, wgm;
    __host__ __device__ void init(int M, int N, int G_, int c_, int wgm_ = WGM) { nM = M / BM; nN = N / BM; nwg = nM * nN; G = G_; c = c_; wgm = wgm_; }
    __host__ __device__ bool next(int i, Unit& u) const {
        const long L = (long)i * G + c; if (L >= nwg) return false;
        int wgid = (int)L; { const int q = nwg / NXCD, r = nwg % NXCD, xcd = wgid % NXCD, off = wgid / NXCD; wgid = (xcd < r ? xcd * (q + 1) : r * (q + 1) + (xcd - r) * q) + off; }
        const int nig = wgm * nN, gid = wgid / nig, fm = gid * wgm, gsz = (nM - fm) < wgm ? (nM - fm) : wgm;
        u.pm = fm + ((wgid % nig) % gsz); u.pn = (wgid % nig) / gsz; return true;
    }
    __device__ __forceinline__ void a_ready(const Unit&) const {}
    __device__ __forceinline__ void done(const Unit&) const {}
};

__device__ __forceinline__ unsigned cvt_pk_bf16(float lo, float hi) { unsigned r; asm volatile("v_cvt_pk_bf16_f32 %0, %1, %2" : "=v"(r) : "v"(lo), "v"(hi)); return r; }
__device__ __forceinline__ float silu_f(float g) { return g * __builtin_amdgcn_rcpf(1.0f + __builtin_amdgcn_exp2f(-1.4426950408889634f * g)); }

constexpr int EM = 8192, ED = 2048, EFF = 5632, ENMOD = 18432, ESEQ = 4096;

struct EpiSwiGLU {
    static constexpr bool PERM = true, AFTER_DRAIN = false;
    bf16_t* H;
    __device__ __forceinline__ void operator()(const f32x4 (&acc)[2][2][4][2], const Unit& u, int wr, int wc, int fr, int fq) const {
        const int row0 = u.pm * BM + wr * 64 + fr, col0 = u.pn * 128 + wc * 32 + 8 * fq;
#pragma unroll
        for (int ai = 0; ai < 2; ++ai)
#pragma unroll
            for (int m = 0; m < 4; ++m) {
                const int rr = row0 + ai * HALF + m * 16;
                bf16_t* rowp = H + (((size_t)(rr >> 8) * (EFF / 64) + (col0 >> 6)) * 256 + (rr & 255)) * 64 + (col0 & 63);
                const f32x4 g0 = acc[ai][0][m][0], g1 = acc[ai][0][m][1], u0 = acc[ai][1][m][0], u1 = acc[ai][1][m][1];
                u32x4 w;
                w.x = cvt_pk_bf16(silu_f(g0[0]) * u0[0], silu_f(g0[1]) * u0[1]); w.y = cvt_pk_bf16(silu_f(g0[2]) * u0[2], silu_f(g0[3]) * u0[3]);
                w.z = cvt_pk_bf16(silu_f(g1[0]) * u1[0], silu_f(g1[1]) * u1[1]); w.w = cvt_pk_bf16(silu_f(g1[2]) * u1[2], silu_f(g1[3]) * u1[3]);
                *(u32x4*)rowp = w;
            }
    }
};
typedef _Float16 h16x2_t __attribute__((ext_vector_type(2)));
typedef float f32x2e_t __attribute__((ext_vector_type(2)));
__device__ __forceinline__ unsigned pk_h16(float a, float b) { const f32x2e_t v = {a, b}; const h16x2_t h = __builtin_convertvector(v, h16x2_t); return __builtin_bit_cast(unsigned, h); }
__device__ __forceinline__ f32x2e_t up_h16(unsigned w) { const h16x2_t h = __builtin_bit_cast(h16x2_t, w); return __builtin_convertvector(h, f32x2e_t); }
template <bool BIN, bool BOUT, int GS2>
struct EpiResid {
    static constexpr bool PERM = true, AFTER_DRAIN = false;
    const void* base; void* out; const float* gate;
    __device__ __forceinline__ void operator()(const f32x4 (&acc)[2][2][4][2], const Unit& u, int wr, int wc, int fr, int fq) const {
        const int row0 = u.pm * BM + wr * 64 + fr, col0 = u.pn * BM + wc * 32 + 8 * fq, b = u.pm >> 4;
        f32x4 gv[2][2];
#pragma unroll
        for (int bj = 0; bj < 2; ++bj)
#pragma unroll
            for (int n = 0; n < 2; ++n) gv[bj][n] = *(const f32x4*)(gate + (size_t)b * ENMOD + col0 + bj * HALF + 4 * n) * (0.5f * GS2);
#pragma unroll
        for (int ai = 0; ai < 2; ++ai) {
            f32x4 bsf[4][2][2]; u32x4 bsw[4][2];
#pragma unroll
            for (int m = 0; m < 4; ++m) { const size_t off = (size_t)(row0 + ai * HALF + m * 16) * ED + col0;
#pragma unroll
                for (int bj = 0; bj < 2; ++bj) { const size_t o2 = off + bj * HALF;
                    if (BIN) bsw[m][bj] = __builtin_nontemporal_load((const u32x4*)((const bf16_t*)base + o2));
                    else { bsf[m][bj][0] = __builtin_nontemporal_load((const f32x4*)((const float*)base + o2)); bsf[m][bj][1] = __builtin_nontemporal_load((const f32x4*)((const float*)base + o2 + 4)); } } }
#pragma unroll
            for (int m = 0; m < 4; ++m) { const size_t off = (size_t)(row0 + ai * HALF + m * 16) * ED + col0;
#pragma unroll
                for (int bj = 0; bj < 2; ++bj) { const size_t o2 = off + bj * HALF; f32x4 b0, b1;
                    if (BIN) { const u32x4 w = bsw[m][bj];
                        const f32x2e_t u0 = up_h16(w.x), u1 = up_h16(w.y), u2 = up_h16(w.z), u3 = up_h16(w.w);
                        b0 = (f32x4){u0.x, u0.y, u1.x, u1.y}; b1 = (f32x4){u2.x, u2.y, u3.x, u3.y}; }
                    else { b0 = bsf[m][bj][0]; b1 = bsf[m][bj][1]; }
                    const f32x4 h0 = b0 + gv[bj][0] * acc[ai][bj][m][0], h1 = b1 + gv[bj][1] * acc[ai][bj][m][1];
                    if (BOUT) { u32x4 w; w.x = pk_h16(h0[0], h0[1]); w.y = pk_h16(h0[2], h0[3]); w.z = pk_h16(h1[0], h1[1]); w.w = pk_h16(h1[2], h1[3]); *(u32x4*)((bf16_t*)out + o2) = w; }
                    else { __builtin_nontemporal_store(h0, (f32x4*)((float*)out + o2)); __builtin_nontemporal_store(h1, (f32x4*)((float*)out + o2 + 4)); } } }
            asm volatile("" ::: "memory");
        }
    }
};
struct EpiQKV {
    static constexpr bool PERM = true, AFTER_DRAIN = false;
    bf16_t* QKV; float* ssq; const float* gains; const float* rope;
    __device__ __forceinline__ void operator()(const f32x4 (&acc)[2][2][4][2], const Unit& u, int wr, int wc, int fr, int fq) const {
        const int row0 = u.pm * BM + wr * 64 + fr;
        const int kind = u.pn >> 3, pl = u.pn & 7;
        bf16_t* dst = QKV + (size_t)kind * ((size_t)EM * ED);
        const int cbase = pl * 256 + wc * 32 + 8 * fq;
        if (kind == 2) {
#pragma unroll
            for (int ai = 0; ai < 2; ++ai)
#pragma unroll
                for (int m = 0; m < 4; ++m) { bf16_t* rowp = dst + (size_t)(row0 + ai * HALF + m * 16) * ED + cbase;
#pragma unroll
                    for (int bj = 0; bj < 2; ++bj) { const f32x4 v0 = acc[ai][bj][m][0], v1 = acc[ai][bj][m][1]; u32x4 w;
                        w.x = cvt_pk_bf16(v0[0], v0[1]); w.y = cvt_pk_bf16(v0[2], v0[3]); w.z = cvt_pk_bf16(v1[0], v1[1]); w.w = cvt_pk_bf16(v1[2], v1[3]);
                        *(u32x4*)(rowp + bj * HALF) = w; } }
            return;
        }
        const bool dil = pl >= 4;
        const float* gn = gains + (kind * 2 + (dil ? 1 : 0)) * 128;
        f32x4 g0, g1;
        if (wc == 0) { g0 = *(const f32x4*)(gn + 4 * fq); g1 = *(const f32x4*)(gn + 16 + 4 * fq); }
        else { g0 = *(const f32x4*)(gn + wc * 32 + 8 * fq); g1 = *(const f32x4*)(gn + wc * 32 + 8 * fq + 4); }
        const bool do_rope = dil && wc == 0;
#pragma unroll
        for (int ai = 0; ai < 2; ++ai)
#pragma unroll
            for (int m = 0; m < 4; ++m) {
                const int row = row0 + ai * HALF + m * 16;
                f32x4 cs0 = {1.f, 0.f, 1.f, 0.f}, cs1 = {1.f, 0.f, 1.f, 0.f};
                if (do_rope) { const float* rp = rope + ((size_t)(row & (ESEQ - 1)) * 16 + 4 * fq) * 2; cs0 = *(const f32x4*)rp; cs1 = *(const f32x4*)(rp + 4); }
#pragma unroll
                for (int bj = 0; bj < 2; ++bj) {
                    const f32x4 r0 = acc[ai][bj][m][0], r1 = acc[ai][bj][m][1];
                    float ss = (r0[0] * r0[0] + r0[1] * r0[1]) + (r0[2] * r0[2] + r0[3] * r0[3]) + (r1[0] * r1[0] + r1[1] * r1[1]) + (r1[2] * r1[2] + r1[3] * r1[3]);
                    ss += __shfl_xor(ss, 16); ss += __shfl_xor(ss, 32);
                    const int head = 2 * pl + bj;
                    if (fq == 0) ssq[(size_t)(wc * 32 + kind * 16 + head) * EM + row] = ss;
                    f32x4 x1 = r0 * g0, x2 = r1 * g1;
                    if (do_rope) {
                        const f32x4 c = {cs0[0], cs0[2], cs1[0], cs1[2]}, s = {cs0[1], cs0[3], cs1[1], cs1[3]};
                        const f32x4 y1 = x1 * c - x2 * s, y2 = x2 * c + x1 * s; x1 = y1; x2 = y2;
                    }
                    u32x4 w; w.x = cvt_pk_bf16(x1[0], x1[1]); w.y = cvt_pk_bf16(x1[2], x1[3]); w.z = cvt_pk_bf16(x2[0], x2[1]); w.w = cvt_pk_bf16(x2[2], x2[3]);
                    *(u32x4*)(dst + (size_t)row * ED + cbase + bj * HALF) = w;
                }
            }
    }
};

template <class Epi, class Sched, bool ALIGN_EPI = false, bool SP2 = false, bool BLKA = false, bool BLKB = false>
__device__ __forceinline__ void gemm_phase(PG8_LAS unsigned char* lds, const Gemm g, const Sched& S, const Epi& E) {
    const int tid = threadIdx.x, wid = __builtin_amdgcn_readfirstlane(tid >> 6), lane = tid & 63, wr = wid >> 2, wc = wid & 3, fr = lane & 15, fq = lane >> 4;
    const int K = g.K, nt = K / BK;
    unsigned voffA[2], voffB[2];
#pragma unroll
    for (int i = 0; i < 2; ++i) { int R, C; stage_rc(tid * 16 + i * 8192, R, C); const int Rb = Epi::PERM ? ((R & ~31) + perm32(R & 31)) : R;
        voffA[i] = (unsigned)(R * (BLKA ? BK : K) + C) * 2u; voffB[i] = (unsigned)(Rb * (BLKB ? BK : K) + C) * 2u; }
    const size_t kstepA = BLKA ? (size_t)(BM * BK * 2) : (size_t)(BK * 2), kstepB = BLKB ? (size_t)(BM * BK * 2) : (size_t)(BK * 2);
    const size_t hstepA = BLKA ? (size_t)(HALF * BK * 2) : (size_t)HALF * K * 2, hstepB = BLKB ? (size_t)(HALF * BK * 2) : (size_t)HALF * K * 2;
    const size_t tstep = (size_t)BM * K * 2;
    const unsigned ldsw = (unsigned)wid * 1024u;
    const int aoff = lds_byte(wr * 64 + fr, fq * 8), boff = lds_byte(wc * 32 + fr, fq * 8);
#define PG8_SA(b, h) (((b) * 2 + (h)) * HTB)
#define PG8_SB(b, h) ((4 + (b) * 2 + (h)) * HTB)
#define PG8_STAGE(bufoff, gbase, voff) do { _Pragma("unroll") for (int _i = 0; _i < 2; ++_i) \
        __builtin_amdgcn_global_load_lds((const unsigned*)((const char*)(gbase) + (voff)[_i]), (PG8_LAS unsigned*)(lds + (bufoff) + ldsw + _i * 8192), 16, 0, 0); } while (0)
#define PG8_LDA(dst, b, h) do { _Pragma("unroll") for (int m = 0; m < 4; ++m) _Pragma("unroll") for (int k = 0; k < 2; ++k) dst[m][k] = *(const PG8_LAS bf16x8*)(lds + PG8_SA(b, h) + aoff + m * 2048 + k * 1024); } while (0)
#define PG8_LDB(dst, b, h) do { _Pragma("unroll") for (int n = 0; n < 2; ++n) _Pragma("unroll") for (int k = 0; k < 2; ++k) dst[n][k] = *(const PG8_LAS bf16x8*)(lds + PG8_SB(b, h) + boff + n * 2048 + k * 1024); } while (0)
#define PG8_MMA(ai, bj, At, Bt) do { __builtin_amdgcn_s_setprio(1); _Pragma("unroll") for (int m = 0; m < 4; ++m) _Pragma("unroll") for (int n = 0; n < 2; ++n) _Pragma("unroll") for (int k = 0; k < 2; ++k) \
        acc[ai][bj][m][n] = __builtin_amdgcn_mfma_f32_16x16x32_bf16(Bt[n][k], At[m][k], acc[ai][bj][m][n], 0, 0, 0); __builtin_amdgcn_s_setprio(0); } while (0)
#define PG8_WAIT_V(n) asm volatile("s_waitcnt vmcnt(" #n ")" ::: "memory")
#define PG8_WAIT_L(n) asm volatile("s_waitcnt lgkmcnt(" #n ")" ::: "memory")
#define PG8_BAR __builtin_amdgcn_s_barrier()
#define PG8_SCHED __builtin_amdgcn_sched_barrier(0)
    Unit cur, nxt; int ui = 0;
    if (!S.next(0, cur)) return;
    f32x4 acc[2][2][4][2];
#pragma unroll
    for (int a = 0; a < 2; ++a)
#pragma unroll
        for (int b = 0; b < 2; ++b)
#pragma unroll
            for (int m = 0; m < 4; ++m)
#pragma unroll
                for (int n = 0; n < 2; ++n) acc[a][b][m][n] = (f32x4){0.f, 0.f, 0.f, 0.f};
    bf16x8 At[4][2], B0[2][2], B1[2][2];
    const char* cA = (const char*)g.A + (size_t)cur.pm * tstep; const char* cB = (const char*)g.Bt + (size_t)cur.pn * tstep;
    S.a_ready(cur);
    if constexpr (SP2) {
        PG8_STAGE(PG8_SB(0, 0), cB, voffB); PG8_STAGE(PG8_SB(0, 1), cB + hstepB, voffB); PG8_STAGE(PG8_SA(0, 0), cA, voffA); PG8_STAGE(PG8_SA(0, 1), cA + hstepA, voffA);
        if (wr == 1) PG8_BAR;
        PG8_WAIT_V(2); PG8_BAR;
        PG8_STAGE(PG8_SB(1, 0), cB + kstepB, voffB); PG8_STAGE(PG8_SA(1, 0), cA + kstepA, voffA); PG8_STAGE(PG8_SB(1, 1), cB + hstepB + kstepB, voffB);
        PG8_WAIT_V(6); PG8_BAR;
    } else {
        PG8_STAGE(PG8_SB(0, 0), cB, voffB); PG8_STAGE(PG8_SA(0, 0), cA, voffA); PG8_STAGE(PG8_SB(0, 1), cB + hstepB, voffB); PG8_STAGE(PG8_SA(0, 1), cA + hstepA, voffA);
        if (wr == 1) PG8_BAR;
        PG8_WAIT_V(4); PG8_BAR;
        PG8_STAGE(PG8_SB(1, 0), cB + kstepB, voffB); PG8_STAGE(PG8_SA(1, 0), cA + kstepA, voffA); PG8_STAGE(PG8_SB(1, 1), cB + hstepB + kstepB, voffB);
        PG8_WAIT_V(6); PG8_BAR;
    }
    for (;;) {
        const bool has_next = S.next(ui + 1, nxt);
        const char* nA = has_next ? (const char*)g.A + (size_t)nxt.pm * tstep : cA; const char* nB = has_next ? (const char*)g.Bt + (size_t)nxt.pn * tstep : cB;
        for (int t = 0; t < nt; t += 2) {
            const bool last = (t == nt - 2);
            const char* a1 = cA + (size_t)(t + 1) * kstepA;
            const char* a2 = last ? nA : cA + (size_t)(t + 2) * kstepA; const char* b2 = last ? nB : cB + (size_t)(t + 2) * kstepB;
            const char* a3 = a2 + kstepA; const char* b3 = b2 + kstepB;
            if (last && has_next) S.a_ready(nxt);
            if constexpr (SP2) {
            PG8_LDB(B0, 0, 0); PG8_LDB(B1, 0, 1); PG8_SCHED; PG8_LDA(At, 0, 0); PG8_STAGE(PG8_SA(1, 1), a1 + hstepA, voffA);
            PG8_WAIT_V(8); PG8_WAIT_L(0); PG8_BAR; PG8_MMA(0, 0, At, B0); PG8_MMA(0, 1, At, B1); PG8_BAR; PG8_SCHED;
            PG8_LDA(At, 0, 1); PG8_STAGE(PG8_SB(0, 0), b2, voffB); PG8_STAGE(PG8_SB(0, 1), b2 + hstepB, voffB); PG8_STAGE(PG8_SA(0, 0), a2, voffA);
            PG8_WAIT_V(8); PG8_WAIT_L(0); PG8_BAR; PG8_MMA(1, 0, At, B0); PG8_MMA(1, 1, At, B1); PG8_BAR; PG8_SCHED;
            PG8_LDB(B0, 1, 0); PG8_LDB(B1, 1, 1); PG8_SCHED; PG8_LDA(At, 1, 0); PG8_STAGE(PG8_SA(0, 1), a2 + hstepA, voffA);
            PG8_WAIT_V(8); PG8_WAIT_L(0); PG8_BAR; PG8_MMA(0, 0, At, B0); PG8_MMA(0, 1, At, B1); PG8_BAR; PG8_SCHED;
            PG8_LDA(At, 1, 1); PG8_STAGE(PG8_SB(1, 0), b3, voffB); PG8_STAGE(PG8_SB(1, 1), b3 + hstepB, voffB); PG8_STAGE(PG8_SA(1, 0), a3, voffA);
            PG8_WAIT_V(8); PG8_WAIT_L(0); PG8_BAR; PG8_MMA(1, 0, At, B0); PG8_MMA(1, 1, At, B1); PG8_BAR; PG8_SCHED;
            } else {
            PG8_LDB(B0, 0, 0); PG8_SCHED; PG8_LDA(At, 0, 0); PG8_STAGE(PG8_SA(1, 1), a1 + hstepA, voffA);
            PG8_WAIT_L(8); PG8_BAR; PG8_WAIT_L(0); PG8_MMA(0, 0, At, B0); PG8_BAR; PG8_SCHED;
            PG8_LDB(B1, 0, 1); PG8_STAGE(PG8_SB(0, 0), b2, voffB);
            PG8_BAR; PG8_WAIT_L(0); PG8_MMA(0, 1, At, B1); PG8_BAR;
            PG8_LDA(At, 0, 1); PG8_STAGE(PG8_SA(0, 0), a2, voffA);
            PG8_BAR; PG8_WAIT_L(0); PG8_MMA(1, 0, At, B0); PG8_BAR; PG8_SCHED;
            PG8_STAGE(PG8_SB(0, 1), b2 + hstepB, voffB);
            PG8_WAIT_V(6); PG8_BAR; PG8_MMA(1, 1, At, B1); PG8_BAR;
            PG8_LDB(B0, 1, 0); PG8_SCHED; PG8_LDA(At, 1, 0); PG8_STAGE(PG8_SA(0, 1), a2 + hstepA, voffA);
            PG8_WAIT_L(8); PG8_BAR; PG8_WAIT_L(0); PG8_MMA(0, 0, At, B0); PG8_BAR; PG8_SCHED;
            PG8_LDB(B1, 1, 1); PG8_STAGE(PG8_SB(1, 0), b3, voffB);
            PG8_BAR; PG8_WAIT_L(0); PG8_MMA(0, 1, At, B1); PG8_BAR;
            PG8_LDA(At, 1, 1); PG8_STAGE(PG8_SA(1, 0), a3, voffA);
            PG8_BAR; PG8_WAIT_L(0); PG8_MMA(1, 0, At, B0); PG8_BAR; PG8_SCHED;
            PG8_STAGE(PG8_SB(1, 1), b3 + hstepB, voffB);
            PG8_WAIT_V(6); PG8_BAR; PG8_MMA(1, 1, At, B1); PG8_BAR;
            }
        }
        if constexpr (ALIGN_EPI) { if (wr == 0) PG8_BAR; }
        if constexpr (!Epi::AFTER_DRAIN) { E(acc, cur, wr, wc, fr, fq); S.done(cur); }
        if (!has_next) break;
#pragma unroll
        for (int a = 0; a < 2; ++a)
#pragma unroll
            for (int b = 0; b < 2; ++b)
#pragma unroll
                for (int m = 0; m < 4; ++m)
#pragma unroll
                    for (int n = 0; n < 2; ++n) acc[a][b][m][n] = (f32x4){0.f, 0.f, 0.f, 0.f};
        cur = nxt; cA = nA; cB = nB; ++ui;
        if constexpr (ALIGN_EPI) { if (wr == 1) PG8_BAR; }
    }
    PG8_WAIT_V(0);
    if constexpr (!ALIGN_EPI) { if (wr == 0) PG8_BAR; }
    PG8_BAR;
    if constexpr (Epi::AFTER_DRAIN) { E.fused(acc, cur, wr, wc, fr, fq, lds, wid, lane); S.done(cur); }
#undef PG8_SA
#undef PG8_SB
#undef PG8_STAGE
#undef PG8_LDA
#undef PG8_LDB
#undef PG8_MMA
#undef PG8_WAIT_V
#undef PG8_WAIT_L
#undef PG8_BAR
#undef PG8_SCHED
}
}
using pg8::bf16_t; using pg8::bf16x8; using pg8::f32x4; using pg8::u32x4;
#define LAS __attribute__((address_space(3)))
typedef short s16x4 __attribute__((ext_vector_type(4)));
typedef float f32x2_t __attribute__((ext_vector_type(2))); typedef __bf16 bf16x2_t __attribute__((ext_vector_type(2)));
typedef unsigned u32x2 __attribute__((ext_vector_type(2)));
__device__ __forceinline__ unsigned cvtpk_s(float lo, float hi) { f32x2_t v = {lo, hi}; bf16x2_t b = __builtin_convertvector(v, bf16x2_t); return __builtin_bit_cast(unsigned, b); }
__device__ __forceinline__ float bf2f(unsigned short h) { return __uint_as_float((unsigned)h << 16); }
__device__ __forceinline__ float bflo(unsigned w) { return __uint_as_float(w << 16); }
__device__ __forceinline__ float bfhi(unsigned w) { return __uint_as_float(w & 0xffff0000u); }
__device__ __forceinline__ float wave_sum(float v) {
#pragma unroll
    for (int o = 1; o < 64; o <<= 1) v += __shfl_xor(v, o);
    return v;
}

constexpr int M_ = 8192, D_ = 2048, FF_ = 5632, SEQ_ = 4096, NMOD_ = 18432;
constexpr float EPS_ = 1e-6f;
constexpr size_t MiB = 1u << 20;
constexpr size_t WS_MOD = 0;
constexpr size_t WS_BAR = 160 * 1024;
constexpr size_t WS_ZERO_BYTES = 256 * 1024;
constexpr int MISC_OFF = 147456 - 64;
constexpr size_t WS_ROPE = 1 * MiB;
constexpr size_t WS_GAIN = 1 * MiB + 512 * 1024;
constexpr size_t WS_SSQ = 2 * MiB;
constexpr size_t WS_LSE = 6 * MiB;
constexpr size_t WS_WGU1 = 8 * MiB, WS_WD1 = 52 * MiB, WS_WQKV = 74 * MiB, WS_WO = 98 * MiB, WS_WGU2 = 106 * MiB, WS_WD2 = 150 * MiB;
constexpr size_t WS_A = 172 * MiB;
constexpr size_t WS_H = 204 * MiB;
constexpr size_t WS_Q = 292 * MiB, WS_K = 324 * MiB, WS_V = 356 * MiB;
constexpr size_t WS_ONA = 388 * MiB;
constexpr size_t WS_ODIL = 404 * MiB;
constexpr size_t WS_HB = 452 * MiB;
constexpr size_t WS_END = 484 * MiB;
constexpr int LDS_BYTES = 147456;
constexpr int NWAVES = 8;

__device__ __forceinline__ int pos_of(int d) { return d < 16 ? 8 * (d >> 2) + (d & 3) : 8 * ((d - 16) >> 2) + 4 + (d & 3); }
__device__ __forceinline__ void tr_item(const float* __restrict__ W, int K, int N, bf16_t* WT, int mode, LAS float* scr, int item, int lane, bool blk = false) {
    const int nblk = N / 32, kb = item / nblk, nb = item - kb * nblk, k0 = 64 * kb, n0 = 32 * nb;
#pragma unroll 16
    for (int i = 0; i < 32; ++i) { const int kk = 2 * i + (lane >> 5); scr[kk * 33 + (lane & 31)] = W[(size_t)(k0 + kk) * N + n0 + (lane & 31)]; }
    asm volatile("s_waitcnt lgkmcnt(0)" ::: "memory");
    const int c = lane & 7;
    int rb = n0; bool perm = false;
    if (mode == 1) rb = ((n0 >> 7) << 8) + (n0 & 127); else if (mode == 2) rb = ((n0 >> 7) << 8) + 128 + (n0 & 127); else if (mode == 3) perm = (n0 < 4096) && ((n0 & 127) == 0);
#pragma unroll
    for (int j = 0; j < 4; ++j) { const int n = (lane >> 3) + 8 * j; const LAS float* s = scr + (8 * c) * 33 + n;
        u32x4 o; o.x = cvtpk_s(s[0 * 33], s[1 * 33]); o.y = cvtpk_s(s[2 * 33], s[3 * 33]); o.z = cvtpk_s(s[4 * 33], s[5 * 33]); o.w = cvtpk_s(s[6 * 33], s[7 * 33]);
        const int dr = rb + (perm ? pos_of(n) : n);
        const size_t di = blk ? ((((size_t)(dr >> 8) * (K >> 6) + (k0 >> 6)) * 256 + (dr & 255)) * 64 + 8 * c) : ((size_t)dr * K + k0 + 8 * c);
        *(u32x4*)(WT + di) = o; }
    asm volatile("s_waitcnt lgkmcnt(0)" ::: "memory");
}
__device__ __forceinline__ void mod_item(const float* __restrict__ cvec, const float* __restrict__ w_ada, const float* __restrict__ b_ada, float* mod, int item, int lane) {
    const int cg_ = item % 72, kc = item / 72, col = cg_ * 256 + lane * 4;
    const float* W = w_ada + (size_t)(kc * 128) * NMOD_ + col;
    f32x4 a0 = {0.f, 0.f, 0.f, 0.f}, a1 = {0.f, 0.f, 0.f, 0.f};
    for (int k = 0; k < 128; k += 8) {
        f32x4 w[8];
#pragma unroll
        for (int j = 0; j < 8; ++j) w[j] = __builtin_nontemporal_load((const f32x4*)(W + (size_t)(k + j) * NMOD_));
#pragma unroll
        for (int j = 0; j < 8; ++j) { const float c0 = pg8::silu_f(cvec[kc * 128 + k + j]), c1 = pg8::silu_f(cvec[D_ + kc * 128 + k + j]); a0 += w[j] * c0; a1 += w[j] * c1; }
    }
    if (kc == 0) { const f32x4 bb = *(const f32x4*)(b_ada + col); a0 += bb; a1 += bb; }
#pragma unroll
    for (int i = 0; i < 4; ++i) { __hip_atomic_fetch_add(mod + col + i, a0[i], __ATOMIC_RELAXED, __HIP_MEMORY_SCOPE_AGENT); __hip_atomic_fetch_add(mod + NMOD_ + col + i, a1[i], __ATOMIC_RELAXED, __HIP_MEMORY_SCOPE_AGENT); }
}
__device__ const float ROPE_INV[16] = {1.0f, 0.44036659598350525f, 0.1939227432012558f, 0.08539710193872452f, 0.03760603070259094f, 0.016560440883040428f, 0.007292664609849453f, 0.0032114461064338684f,
    0.0014142135623842478f, 0.0006227724370546639f, 0.00027424818836152554f, 0.00012076973507646471f, 5.3182957344688475e-05f, 2.34199997066753e-05f, 1.0313385246263351e-05f, 4.541670477919979e-06f};
__device__ __forceinline__ void rope_entry(float* rope, int idx) {
    const int pos = idx >> 4, f = idx & 15;
    const float inv = ROPE_INV[f];
    const float ang = (float)pos * inv;
    const double x = (double)ang;
    const double q = rint(x * 0.63661977236758134308);
    double y = fma(-q, 1.57079632679489655800, x); y = fma(-q, 6.12323399573676603587e-17, y);
    const double y2 = y * y;
    double sp = -2.50521083854417187751e-08; sp = fma(sp, y2, 2.75573192239858906526e-06); sp = fma(sp, y2, -1.98412698412698412698e-04); sp = fma(sp, y2, 8.33333333333333333333e-03); sp = fma(sp, y2, -1.66666666666666666667e-01);
    const double sn = fma(y * y2, sp, y);
    double cp = 2.08767569878680989792e-09; cp = fma(cp, y2, -2.75573192239858906526e-07); cp = fma(cp, y2, 2.48015873015873015873e-05); cp = fma(cp, y2, -1.38888888888888888889e-03); cp = fma(cp, y2, 4.16666666666666666667e-02); cp = fma(cp, y2, -0.5);
    const double cn = fma(y2, cp, 1.0);
    const int qi = ((int)q) & 3;
    const double s = (qi == 0) ? sn : (qi == 1) ? cn : (qi == 2) ? -sn : -cn;
    const double c = (qi == 0) ? cn : (qi == 1) ? -sn : (qi == 2) ? -cn : sn;
    rope[2 * idx] = (float)c; rope[2 * idx + 1] = (float)s;
}
struct In { const float *x, *c, *w_ada, *b_ada, *g_ffn1, *w1_gate, *w1_up, *w1_down, *g_mix, *w_qkv, *qn_na, *kn_na, *qn_dil, *kn_dil, *rpb_na, *g_out_na, *g_out_dil, *w_o, *g_ffn2, *w2_gate, *w2_up, *w2_down; };
struct TrD { const float* W; bf16_t* WT; int K, N, mode, blk, item; };
__device__ __forceinline__ TrD tr_desc(const In& I, unsigned char* ws, int list, int it) {
    constexpr int NG = 5632; TrD d; d.blk = 1; d.mode = 0; d.K = D_; d.N = FF_; d.item = it; d.W = I.w1_gate; d.WT = (bf16_t*)(ws + WS_WGU1);
    if (list == 0) {
        if (it < NG) { d.mode = 1; }
        else if (it < 2 * NG) { d.W = I.w1_up; d.mode = 2; d.item = it - NG; }
        else if (it < 2 * NG + 2048) { d.W = I.w_o; d.WT = (bf16_t*)(ws + WS_WO); d.N = D_; d.item = it - 2 * NG; }
        else if (it < 3 * NG + 2048) { d.W = I.w2_gate; d.WT = (bf16_t*)(ws + WS_WGU2); d.mode = 1; d.item = it - 2 * NG - 2048; }
        else { d.W = I.w2_up; d.WT = (bf16_t*)(ws + WS_WGU2); d.mode = 2; d.item = it - 3 * NG - 2048; }
    } else if (list == 1) {
        if (it < NG) { d.W = I.w1_down; d.WT = (bf16_t*)(ws + WS_WD1); d.K = FF_; d.N = D_; d.blk = 1; }
        else { d.W = I.w_qkv; d.WT = (bf16_t*)(ws + WS_WQKV); d.N = 3 * D_; d.mode = 3; d.item = it - NG; }
    } else { d.W = I.w2_down; d.WT = (bf16_t*)(ws + WS_WD2); d.K = FF_; d.N = D_; d.blk = 1; }
    return d;
}
__device__ __forceinline__ void tr_load(const TrD& d, f32x4 (&v)[8], int lane) {
    const int nblk = d.N / 32, kb = d.item / nblk, nb = d.item - kb * nblk, k0 = 64 * kb, n0 = 32 * nb, kl = lane & 7, nl = lane >> 3;
    const float* p = d.W + (size_t)(k0 + 8 * kl) * d.N + n0 + 4 * nl;
#pragma unroll
    for (int e = 0; e < 8; ++e) v[e] = __builtin_nontemporal_load((const f32x4*)(p + (size_t)e * d.N));
}
__device__ __forceinline__ void tr_store(const TrD& d, const f32x4 (&v)[8], int lane) {
    const int nblk = d.N / 32, kb = d.item / nblk, nb = d.item - kb * nblk, k0 = 64 * kb, n0 = 32 * nb, kl = lane & 7, nl = lane >> 3, K = d.K;
    int rb = n0; bool perm = false;
    if (d.mode == 1) rb = ((n0 >> 7) << 8) + (n0 & 127); else if (d.mode == 2) rb = ((n0 >> 7) << 8) + 128 + (n0 & 127); else if (d.mode == 3) perm = (n0 < 4096) && ((n0 & 127) == 0);
#pragma unroll
    for (int i = 0; i < 4; ++i) { const int n = 4 * nl + i, dr = rb + (perm ? pos_of(n) : n);
        u32x4 o; o.x = cvtpk_s(v[0][i], v[1][i]); o.y = cvtpk_s(v[2][i], v[3][i]); o.z = cvtpk_s(v[4][i], v[5][i]); o.w = cvtpk_s(v[6][i], v[7][i]);
        const size_t di = d.blk ? ((((size_t)(dr >> 8) * (K >> 6) + (k0 >> 6)) * 256 + (dr & 255)) * 64 + 8 * kl) : ((size_t)dr * K + k0 + 8 * kl);
        *(u32x4*)(d.WT + di) = o; }
}
__device__ __forceinline__ void tr_run(const In& I, unsigned char* ws, int list, int it0, int step, int end, int lane) {
    int it = it0;
    for (; it + step < end; it += 2 * step) { const TrD a = tr_desc(I, ws, list, it), b = tr_desc(I, ws, list, it + step); f32x4 va[8], vb[8];
        tr_load(a, va, lane); tr_load(b, vb, lane); tr_store(a, va, lane); tr_store(b, vb, lane); }
    if (it < end) { const TrD a = tr_desc(I, ws, list, it); f32x4 va[8]; tr_load(a, va, lane); tr_store(a, va, lane); }
}
constexpr int TR_N0 = 4 * 5632 + 2048, TR_N1 = 5632 + 6144, TR_N2 = 5632;
__device__ __forceinline__ void p0_prologue(const In& I, unsigned char* ws, LAS unsigned char* lds, int gw, int NGW, int wave, int lane, bool do_mod) {
    LAS float* scr = (LAS float*)(lds + wave * 16384);
    float* mod = (float*)(ws + WS_MOD);
    if (do_mod) for (int it = gw; it < 72 * 16; it += NGW) mod_item(I.c, I.w_ada, I.b_ada, mod, it, lane);
    if (NGW == 2048) {
        tr_run(I, ws, 0, gw, 2048, 7 * 2048, lane);
        if (gw >= 1152) tr_run(I, ws, 0, 7 * 2048 + (gw - 1152), 896, TR_N0, lane);
    } else tr_run(I, ws, 0, gw, NGW, TR_N0, lane);
    float* rope = (float*)(ws + WS_ROPE);
    for (int idx = gw * 64 + lane; idx < SEQ_ * 16; idx += NGW * 64) rope_entry(rope, idx);
    if (gw == 0) { float* gains = (float*)(ws + WS_GAIN); gains[lane] = I.qn_na[lane]; gains[64 + lane] = I.qn_na[64 + lane]; gains[128 + lane] = I.qn_dil[lane]; gains[192 + lane] = I.qn_dil[64 + lane];
        gains[256 + lane] = I.kn_na[lane]; gains[320 + lane] = I.kn_na[64 + lane]; gains[384 + lane] = I.kn_dil[lane]; gains[448 + lane] = I.kn_dil[64 + lane]; }
}
__device__ __forceinline__ void tail_convert(const In& I, unsigned char* ws, LAS unsigned char* lds, int G, int wave, int lane, int list, int nitems) {
    const int nwg = (M_ / 256) * (2 * FF_ / 256), rounds = (nwg + G - 1) / G, busy = nwg - (rounds - 1) * G;
    int nidle = G - busy, my = (int)blockIdx.x - busy;
    if (nidle <= 0) { nidle = G; my = (int)blockIdx.x; }
    if (my < 0) return;
    tr_run(I, ws, list, my * NWAVES + wave, nidle * NWAVES, nitems, lane);
}

__device__ __forceinline__ void norm_mod_rows(const float* src, const float* __restrict__ g, const float* mod, int sh_idx, int sc_idx, bf16_t* A, int gw, int NGW, int lane) {
    for (int row = gw; row < M_; row += NGW) {
        const int b = row >> 12;
        const f32x4* xr = (const f32x4*)(src + (size_t)row * D_) + lane;
        f32x4 v[8]; float ss = 0.f;
#pragma unroll
        for (int j = 0; j < 8; ++j) { v[j] = __builtin_nontemporal_load(xr + 64 * j); ss += (v[j][0] * v[j][0] + v[j][1] * v[j][1]) + (v[j][2] * v[j][2] + v[j][3] * v[j][3]); }
        const float r = __builtin_amdgcn_rsqf(wave_sum(ss) * (1.f / D_) + EPS_);
        const float* sh = mod + (size_t)b * NMOD_ + sh_idx * D_; const float* sc = mod + (size_t)b * NMOD_ + sc_idx * D_;
        u32x2* o = (u32x2*)(A + (size_t)row * D_) + lane;
#pragma unroll
        for (int j = 0; j < 8; ++j) { const int k = 4 * lane + 256 * j; const f32x4 gg = *(const f32x4*)(g + k), s1 = *(const f32x4*)(sc + k), s0 = *(const f32x4*)(sh + k);
            const f32x4 y = v[j] * r * gg * (s1 + 1.0f) + s0; u32x2 w; w.x = cvtpk_s(y[0], y[1]); w.y = cvtpk_s(y[2], y[3]); o[64 * j] = w; }
    }
}

__device__ __forceinline__ void norm_mod_rows_bf(const bf16_t* src, const float* __restrict__ g, const float* mod, int sh_idx, int sc_idx, bf16_t* A, int gw, int NGW, int lane) {
    for (int row = gw; row < M_; row += NGW) {
        const int b = row >> 12;
        const u32x4* xr = (const u32x4*)(src + (size_t)row * D_) + lane;
        f32x4 v[4][2]; float ss = 0.f;
#pragma unroll
        for (int j = 0; j < 4; ++j) { const u32x4 w = __builtin_nontemporal_load(xr + 64 * j); { const pg8::f32x2e_t u0 = pg8::up_h16(w.x), u1 = pg8::up_h16(w.y), u2 = pg8::up_h16(w.z), u3 = pg8::up_h16(w.w); v[j][0] = (f32x4){u0.x, u0.y, u1.x, u1.y}; v[j][1] = (f32x4){u2.x, u2.y, u3.x, u3.y}; }
#pragma unroll
            for (int e = 0; e < 2; ++e) ss += (v[j][e][0] * v[j][e][0] + v[j][e][1] * v[j][e][1]) + (v[j][e][2] * v[j][e][2] + v[j][e][3] * v[j][e][3]); }
        const float r = __builtin_amdgcn_rsqf(wave_sum(ss) * (1.f / D_) + EPS_);
        const float* sh = mod + (size_t)b * NMOD_ + sh_idx * D_; const float* sc = mod + (size_t)b * NMOD_ + sc_idx * D_;
        u32x4* o = (u32x4*)(A + (size_t)row * D_) + lane;
#pragma unroll
        for (int j = 0; j < 4; ++j) { const int k = 8 * lane + 512 * j; f32x4 y[2];
#pragma unroll
            for (int e = 0; e < 2; ++e) { const f32x4 gg = *(const f32x4*)(g + k + 4 * e), s1 = *(const f32x4*)(sc + k + 4 * e), s0 = *(const f32x4*)(sh + k + 4 * e); y[e] = v[j][e] * r * gg * (s1 + 1.0f) + s0; }
            u32x4 w; w.x = cvtpk_s(y[0][0], y[0][1]); w.y = cvtpk_s(y[0][2], y[0][3]); w.z = cvtpk_s(y[1][0], y[1][1]); w.w = cvtpk_s(y[1][2], y[1][3]); o[64 * j] = w; }
    }
}

constexpr int KROW = 272;
constexpr int KB_OFF = 0, VB_OFF = 256 * KROW, RK_OFF = 2 * 256 * KROW;
typedef short v4i16_t __attribute__((ext_vector_type(4)));
__device__ __forceinline__ s16x4 vtr(LAS const unsigned char* p) { return __builtin_bit_cast(s16x4, __builtin_amdgcn_ds_read_tr16_b64_v4i16((LAS v4i16_t*)p)); }
#define MFMA16(a, b, c) __builtin_amdgcn_mfma_f32_16x16x32_bf16((a), (b), (c), 0, 0, 0)
struct AttnT { const bf16_t *Q, *K, *V; const float* ssq; const float* rpb; bf16_t* ONA; bf16_t* ODIL; float* LSE; };

constexpr int BIAS_OFF = RK_OFF + 1024;
struct UD { int na, b, r, hp, rs, h, p, dd, rho, sb, nsb; };
__device__ __forceinline__ UD decode_unit(int u) {
    UD d; d.na = u < 512; d.r = 0; d.hp = 0; d.rs = 0; d.h = 0; d.p = 0; d.dd = 1; d.rho = 0; d.sb = 0; d.nsb = 1;
    if (d.na) { d.hp = u & 3; d.r = (u >> 2) & 63; d.b = u >> 8; d.rs = min(max(d.r - 4, 0), 56); }
    else { const int v = u - 512, blk = v & 31; d.p = (v >> 5) % 3; d.h = (v / 96) & 7; d.b = v / 768; const int sh2 = 2 * d.p; d.dd = 1 << sh2; d.rho = blk & (d.dd - 1); d.sb = blk >> sh2; d.nsb = 32 >> sh2; }
    return d;
}
struct CD { int b, tbase, smask, dd, hbase, hsel; };
__device__ __forceinline__ CD chunk_desc(const UD& d, int ck) {
    CD c; c.b = d.b; c.dd = d.dd;
    c.tbase = d.na ? (d.rs + 2 * ck) * 64 : d.rho + (128 * d.sb - 64) * d.dd;
    c.smask = d.na ? 127 : 255; c.hbase = d.na ? 2 * d.hp : 8 + d.h; c.hsel = d.na ? 1 : 0;
    return c;
}
struct Pre { u32x4 k[8]; f32x4 ks4; bf16x8 qf[4]; f32x4 qs4; float bias; };
__device__ __forceinline__ void prefetch_chunk(Pre& P, const AttnT& T, const CD& cd, int tid) {
    const unsigned char* Kg = (const unsigned char*)T.K;
    const int piece = tid & 15;
#pragma unroll
    for (int i = 0; i < 8; ++i) { const int slot = (tid >> 4) + 32 * i;
        const int token = min(max(cd.tbase + (slot & cd.smask) * cd.dd, 0), SEQ_ - 1), khead = cd.hbase + ((slot >> 7) & cd.hsel);
        const unsigned goff = (unsigned)(((cd.b * SEQ_ + token) * D_ + khead * 128) * 2 + piece * 16);
        P.k[i] = *(const u32x4*)(Kg + goff); }
    { const int slot = tid & 255; const int token = min(max(cd.tbase + (slot & cd.smask) * cd.dd, 0), SEQ_ - 1), khead = cd.hbase + ((slot >> 7) & cd.hsel);
        const float* sp = T.ssq + (unsigned)((16 + khead) * M_ + cd.b * SEQ_ + token); P.ks4 = (f32x4){sp[0], sp[32 * M_], sp[64 * M_], sp[96 * M_]}; }
}
__device__ __forceinline__ void load_v(u32x4 (&v)[8], const AttnT& T, const CD& cd, int tid) {
    const unsigned char* Vg = (const unsigned char*)T.V; const int piece = tid & 15;
#pragma unroll
    for (int i = 0; i < 8; ++i) { const int slot = (tid >> 4) + 32 * i;
        const int token = min(max(cd.tbase + (slot & cd.smask) * cd.dd, 0), SEQ_ - 1), khead = cd.hbase + ((slot >> 7) & cd.hsel);
        v[i] = *(const u32x4*)(Vg + (unsigned)(((cd.b * SEQ_ + token) * D_ + khead * 128) * 2 + piece * 16)); }
}
__device__ __forceinline__ void unit_query(const UD& d, int w, int c, int& jq, int& tq, int& head) {
    jq = 16 * (w & (d.na ? 3 : 7)) + c; tq = (d.na ? d.r * 64 : d.rho + 128 * d.sb * d.dd) + jq * d.dd; head = d.na ? 2 * d.hp + (w >> 2) : 8 + d.h;
}
__device__ __forceinline__ void prefetch_q(Pre& P, const AttnT& T, const UD& d, int w, int lane, int tid) {
    int jq, tq, head; unit_query(d, w, lane & 15, jq, tq, head);
    const unsigned rowQ = (unsigned)(d.b * SEQ_ + tq);
    const unsigned char* qp = (const unsigned char*)T.Q + (unsigned)((rowQ * D_ + head * 128 + 8 * (lane >> 4)) * 2);
#pragma unroll
    for (int ks = 0; ks < 4; ++ks) P.qf[ks] = *(const bf16x8*)(qp + 64 * ks);
    { const float* sp = T.ssq + (unsigned)(head * M_) + rowQ; P.qs4 = (f32x4){sp[0], sp[32 * M_], sp[64 * M_], sp[96 * M_]}; }
    { const int hh2 = tid >> 8, i8 = (tid >> 5) & 7, co = min(tid & 31, 30);
      P.bias = T.rpb[((2 * d.hp + hh2) * 15 + (d.rs + i8 - d.r + 7)) * 31 + co] * 1.4426950408889634f; }
}
template <bool NA>
__device__ __forceinline__ void attn_unit(LAS unsigned char* lds, const AttnT& T, const UD& d, const UD& nxt, bool has_next, Pre& P) {
    constexpr int NT = NA ? 4 : 10, NCH = NA ? 4 : 1;
    const int tid = threadIdx.x, lane = tid & 63, w = __builtin_amdgcn_readfirstlane(tid >> 6), c = lane & 15, g = lane >> 4;
    const int hh = w >> 2, qg = w & 3;
    int jq, tq, head; unit_query(d, w, c, jq, tq, head);
    const size_t rowQ = (size_t)d.b * SEQ_ + tq;
    if (NA) prefetch_q(P, T, d, w, lane, tid);
    bf16x8 qf[4];
#pragma unroll
    for (int ks = 0; ks < 4; ++ks) qf[ks] = P.qf[ks];
    const float rq = __builtin_amdgcn_rsqf(((P.qs4[0] + P.qs4[1]) + (P.qs4[2] + P.qs4[3])) * (1.f / 128.f) + EPS_) * (0.08838834764831845f * 1.4426950408889634f);
    const float biasv = P.bias;
    const int W0 = NA ? (qg == 0 ? 0 : qg == 1 ? 8 : qg == 2 ? 24 : 32) : 0;
    const int cs = min(max(jq - 8, 0), 48);
    const int lo_s = (!NA && d.sb == 0) ? 64 : 0, hi_s = (!NA && d.sb == d.nsb - 1) ? 192 : 256;
    f32x4 O[8];
#pragma unroll
    for (int dt = 0; dt < 8; ++dt) O[dt] = (f32x4){0.f, 0.f, 0.f, 0.f};
    float m_run = -1e30f, l_run = 0.f;
    LAS float* rk = (LAS float*)(lds + RK_OFF);
#pragma unroll 1
    for (int ck = 0; ck < NCH; ++ck) {
        u32x4 vreg[8]; load_v(vreg, T, chunk_desc(d, ck), tid);
#pragma unroll
        for (int i = 0; i < 8; ++i) { const int slot = (tid >> 4) + 32 * i, piece = tid & 15;
            *(LAS u32x4*)(lds + KB_OFF + slot * KROW + piece * 16) = P.k[i]; }
        if (tid < 256) rk[tid] = __builtin_amdgcn_rsqf(((P.ks4[0] + P.ks4[1]) + (P.ks4[2] + P.ks4[3])) * (1.f / 128.f) + EPS_);
        if (NA && ck == 0) ((LAS float*)(lds + BIAS_OFF))[tid] = biasv;
        __syncthreads();
        { const CD cdn = (ck + 1 < NCH) ? chunk_desc(d, ck + 1) : chunk_desc(nxt, 0); if (ck + 1 < NCH || has_next) prefetch_chunk(P, T, cdn, tid); }
        f32x4 s[NT]; float mx = -1e30f;
#pragma unroll
        for (int t = 0; t < NT; ++t) {
            const int tb = NA ? hh * 128 + (t >> 1) * 64 + W0 + 16 * (t & 1) : 16 * w + 16 * t;
            if (!NA && t == 9) { s[t] = (f32x4){-1e30f, -1e30f, -1e30f, -1e30f}; continue; }
            f32x4 acc = {0.f, 0.f, 0.f, 0.f};
#pragma unroll
            for (int ks = 0; ks < 4; ++ks) { const bf16x8 a = *(const LAS bf16x8*)(lds + KB_OFF + (tb + c) * KROW + (32 * ks + 8 * g) * 2); acc = MFMA16(a, qf[ks], acc); }
            const f32x4 rk4 = *(const LAS f32x4*)(lds + RK_OFF + (tb + 4 * g) * 4);
#pragma unroll
            for (int i = 0; i < 4; ++i) {
                float v = acc[i] * rq * rk4[i]; bool valid;
                if (NA) { const int kc = W0 + 16 * (t & 1) + 4 * g + i; valid = (kc >= cs) && (kc < cs + 16);
                    const int co = min(max(kc - jq + 15, 0), 30);
                    v += *(const LAS float*)(lds + BIAS_OFF + ((hh * 8 + 2 * ck + (t >> 1)) * 32 + co) * 4); }
                else { const int slot = tb + 4 * g + i; valid = (slot >= lo_s) && (slot < hi_s);
                    if (t == 0) valid = valid && (4 * g + i >= c);
                    if (t == 8) valid = valid && (4 * g + i <= c); }
                v = valid ? v : -1e30f; acc[i] = v; mx = fmaxf(mx, v);
            }
            s[t] = acc;
        }
        if (!NA && ck + 1 >= NCH && has_next) prefetch_q(P, T, nxt, w, lane, tid);
        mx = fmaxf(mx, __shfl_xor(mx, 16)); mx = fmaxf(mx, __shfl_xor(mx, 32));
        const float m_new = fmaxf(m_run, mx), alpha = __builtin_amdgcn_exp2f(m_run - m_new);
        float ls = 0.f;
#pragma unroll
        for (int t = 0; t < NT; ++t)
#pragma unroll
            for (int i = 0; i < 4; ++i) { const float pv = __builtin_amdgcn_exp2f(s[t][i] - m_new); s[t][i] = pv; ls += pv; }
        ls += __shfl_xor(ls, 16); ls += __shfl_xor(ls, 32);
        l_run = l_run * alpha + ls; m_run = m_new;
        if (NA) {
#pragma unroll
            for (int dt = 0; dt < 8; ++dt) O[dt] *= alpha;
        }
#pragma unroll
        for (int i = 0; i < 8; ++i) { const int slot = (tid >> 4) + 32 * i, piece = tid & 15; *(LAS u32x4*)(lds + VB_OFF + slot * KROW + piece * 16) = vreg[i]; }
        __syncthreads();
#pragma unroll
        for (int u = 0; u < NT / 2; ++u) {
            const int t0 = 2 * u, t1 = 2 * u + 1;
            int tb0 = NA ? hh * 128 + (t0 >> 1) * 64 + W0 + 16 * (t0 & 1) : 16 * w + 16 * t0;
            int tb1 = NA ? hh * 128 + (t1 >> 1) * 64 + W0 + 16 * (t1 & 1) : 16 * w + 16 * t1;
            if (!NA) { tb0 = min(tb0, 240); tb1 = min(tb1, 240); }
            u32x4 pw; pw.x = cvtpk_s(s[t0][0], s[t0][1]); pw.y = cvtpk_s(s[t0][2], s[t0][3]); pw.z = cvtpk_s(s[t1][0], s[t1][1]); pw.w = cvtpk_s(s[t1][2], s[t1][3]);
            const bf16x8 pb = __builtin_bit_cast(bf16x8, pw);
            LAS const unsigned char* v0 = lds + VB_OFF + (tb0 + 4 * g + (c >> 2)) * KROW + 8 * (c & 3);
            LAS const unsigned char* v1 = lds + VB_OFF + (tb1 + 4 * g + (c >> 2)) * KROW + 8 * (c & 3);
#pragma unroll
            for (int dt = 0; dt < 8; ++dt) { const s16x4 lo = vtr(v0 + 32 * dt), hi = vtr(v1 + 32 * dt);
                const bf16x8 a = {lo[0], lo[1], lo[2], lo[3], hi[0], hi[1], hi[2], hi[3]}; O[dt] = MFMA16(a, pb, O[dt]); }
        }
    }
    const float inv = __builtin_amdgcn_rcpf(l_run);
    bf16_t* ob = NA ? T.ONA + rowQ * 1024 + head * 128 : T.ODIL + ((size_t)d.p * M_ + rowQ) * 1024 + d.h * 128;
#pragma unroll
    for (int e = 0; e < 4; ++e) {
        const unsigned a0 = cvtpk_s(O[2 * e][0] * inv, O[2 * e][1] * inv), a1 = cvtpk_s(O[2 * e][2] * inv, O[2 * e][3] * inv);
        const unsigned b0 = cvtpk_s(O[2 * e + 1][0] * inv, O[2 * e + 1][1] * inv), b1 = cvtpk_s(O[2 * e + 1][2] * inv, O[2 * e + 1][3] * inv);
        const bool odd = g & 1;
        const unsigned r0 = __shfl_xor(odd ? a0 : b0, 16), r1 = __shfl_xor(odd ? a1 : b1, 16);
        u32x4 wv; if (odd) { wv.x = r0; wv.y = r1; wv.z = b0; wv.w = b1; } else { wv.x = a0; wv.y = a1; wv.z = r0; wv.w = r1; }
        *(u32x4*)(ob + 32 * e + (odd ? 16 + 4 * (g - 1) : 4 * g)) = wv; }
    if (!NA && g == 0) T.LSE[((size_t)d.p * M_ + rowQ) * 8 + d.h] = (m_run + __builtin_amdgcn_logf(l_run)) * 0.6931471805599453f;
}
template <bool NA>
__device__ __forceinline__ int unit_of(int i, int G) {
    const int bx = blockIdx.x;
    if (G != 256) return NA ? bx + i * G : bx + i * G;
    const int x = bx & 7, j = bx >> 3;
    if (NA) return ((x >> 2) << 8) | ((2 * j + i) << 2) | (x & 3);
    const int bh = 2 * x + i / 3, v = j * 3 + (i % 3);
    return bh * 96 + v;
}
template <bool NA>
__device__ __forceinline__ void attn_loop(LAS unsigned char* lds, const AttnT& T, int G) {
    const int nun = NA ? 512 : 1536, ubase = NA ? 0 : 512;
    const int cnt = (G == 256) ? (NA ? 2 : 6) : (nun - (int)blockIdx.x + G - 1) / G;
    if (cnt <= 0) return;
    const int tid = threadIdx.x, lane = tid & 63, w = __builtin_amdgcn_readfirstlane(tid >> 6);
    UD cur = decode_unit(ubase + unit_of<NA>(0, G));
    Pre P; prefetch_chunk(P, T, chunk_desc(cur, 0), tid); if (!NA) prefetch_q(P, T, cur, w, lane, tid);
#pragma unroll 1
    for (int i = 0; i < cnt; ++i) {
        const bool has_next = i + 1 < cnt; const UD nxt = decode_unit(ubase + unit_of<NA>(has_next ? i + 1 : i, G));
        attn_unit<NA>(lds, T, cur, nxt, has_next, P);
        cur = nxt;
    }
    __syncthreads();
}
__device__ __forceinline__ void attn_phase(LAS unsigned char* lds, const AttnT& T, int G) {
    attn_loop<true>(lds, T, G);
    attn_loop<false>(lds, T, G);
}
__device__ __forceinline__ void combine_rows(const bf16_t* ONA, const bf16_t* ODIL, const float* LSE, const float* __restrict__ g_na, const float* __restrict__ g_dil, bf16_t* A, int gw, int NGW, int lane) {
    for (int row = gw; row < M_; row += NGW) {
        float va[2][8], vd[2][8]; float sa = 0.f, sd = 0.f;
#pragma unroll
        for (int j = 0; j < 2; ++j) {
            const int k = 8 * lane + 512 * j;
            const u32x4 x = __builtin_nontemporal_load((const u32x4*)(ONA + (size_t)row * 1024 + k));
            va[j][0] = bflo(x.x); va[j][1] = bfhi(x.x); va[j][2] = bflo(x.y); va[j][3] = bfhi(x.y); va[j][4] = bflo(x.z); va[j][5] = bfhi(x.z); va[j][6] = bflo(x.w); va[j][7] = bfhi(x.w);
            const int hd = k >> 7;
            const float l0 = LSE[((size_t)0 * M_ + row) * 8 + hd], l1 = LSE[((size_t)1 * M_ + row) * 8 + hd], l2 = LSE[((size_t)2 * M_ + row) * 8 + hd];
            const float mm = fmaxf(l0, fmaxf(l1, l2)); float w0 = __expf(l0 - mm), w1 = __expf(l1 - mm), w2 = __expf(l2 - mm); const float wi = 1.f / (w0 + w1 + w2); w0 *= wi; w1 *= wi; w2 *= wi;
            const u32x4 y0 = __builtin_nontemporal_load((const u32x4*)(ODIL + ((size_t)0 * M_ + row) * 1024 + k)), y1 = __builtin_nontemporal_load((const u32x4*)(ODIL + ((size_t)1 * M_ + row) * 1024 + k)), y2 = __builtin_nontemporal_load((const u32x4*)(ODIL + ((size_t)2 * M_ + row) * 1024 + k));
            vd[j][0] = w0 * bflo(y0.x) + w1 * bflo(y1.x) + w2 * bflo(y2.x); vd[j][1] = w0 * bfhi(y0.x) + w1 * bfhi(y1.x) + w2 * bfhi(y2.x);
            vd[j][2] = w0 * bflo(y0.y) + w1 * bflo(y1.y) + w2 * bflo(y2.y); vd[j][3] = w0 * bfhi(y0.y) + w1 * bfhi(y1.y) + w2 * bfhi(y2.y);
            vd[j][4] = w0 * bflo(y0.z) + w1 * bflo(y1.z) + w2 * bflo(y2.z); vd[j][5] = w0 * bfhi(y0.z) + w1 * bfhi(y1.z) + w2 * bfhi(y2.z);
            vd[j][6] = w0 * bflo(y0.w) + w1 * bflo(y1.w) + w2 * bflo(y2.w); vd[j][7] = w0 * bfhi(y0.w) + w1 * bfhi(y1.w) + w2 * bfhi(y2.w);
#pragma unroll
            for (int e = 0; e < 8; ++e) { sa += va[j][e] * va[j][e]; sd += vd[j][e] * vd[j][e]; }
        }
        const float ra = __builtin_amdgcn_rsqf(wave_sum(sa) * (1.f / 1024.f) + EPS_), rd = __builtin_amdgcn_rsqf(wave_sum(sd) * (1.f / 1024.f) + EPS_);
#pragma unroll
        for (int j = 0; j < 2; ++j) {
            const int k = 8 * lane + 512 * j;
            const f32x4 ga0 = *(const f32x4*)(g_na + k), ga1 = *(const f32x4*)(g_na + k + 4), gd0 = *(const f32x4*)(g_dil + k), gd1 = *(const f32x4*)(g_dil + k + 4);
            u32x4 oa, od;
            oa.x = cvtpk_s(va[j][0] * ra * ga0[0], va[j][1] * ra * ga0[1]); oa.y = cvtpk_s(va[j][2] * ra * ga0[2], va[j][3] * ra * ga0[3]);
            oa.z = cvtpk_s(va[j][4] * ra * ga1[0], va[j][5] * ra * ga1[1]); oa.w = cvtpk_s(va[j][6] * ra * ga1[2], va[j][7] * ra * ga1[3]);
            od.x = cvtpk_s(vd[j][0] * rd * gd0[0], vd[j][1] * rd * gd0[1]); od.y = cvtpk_s(vd[j][2] * rd * gd0[2], vd[j][3] * rd * gd0[3]);
            od.z = cvtpk_s(vd[j][4] * rd * gd1[0], vd[j][5] * rd * gd1[1]); od.w = cvtpk_s(vd[j][6] * rd * gd1[2], vd[j][7] * rd * gd1[3]);
            *(u32x4*)(A + (size_t)row * D_ + k) = oa; *(u32x4*)(A + (size_t)row * D_ + 1024 + k) = od;
        }
    }
}

#define XB_TMO      128
#define XB_XCNT(j)  (256  + 64 * (j))
#define XB_XSUB(j)  (1280 + 64 * (j))
#define XB_XGEN(j)  (2304 + 64 * (j))
#define XB_TOP      3328
#define XB_TOPGEN   3392
#define XCD_BAR_WORDS 3456
#define XB_SPIN_CAP (1u << 18)

__device__ __forceinline__ unsigned xb_ld(unsigned* p)              { return __hip_atomic_load(p, __ATOMIC_RELAXED, __HIP_MEMORY_SCOPE_AGENT); }
__device__ __forceinline__ unsigned xb_add(unsigned* p, unsigned v) { return __hip_atomic_fetch_add(p, v, __ATOMIC_RELAXED, __HIP_MEMORY_SCOPE_AGENT); }
__device__ __forceinline__ unsigned xb_xcc_id() { return (unsigned)__builtin_amdgcn_s_getreg((3 << 11) | 20) & 0xFu; }
#define XB_SPIN(cond, bar) do { unsigned _sp = 0; while (cond) { __builtin_amdgcn_s_sleep(1); \
    if ((++_sp & 255u) == 0u) { if (xb_ld(&(bar)[XB_TMO])) break; if (_sp > XB_SPIN_CAP) { atomicAdd(&(bar)[XB_TMO], 1u); break; } } } } while (0)

struct XcdBarrier {
    unsigned* bar; unsigned x;
    volatile LAS unsigned* st;
};

__device__ __forceinline__ XcdBarrier xcd_barrier_post(unsigned* bar, volatile LAS unsigned* st) {
    XcdBarrier b; b.bar = bar; b.x = xb_xcc_id(); b.st = st;
    if (threadIdx.x == 0) (void)xb_add(&bar[XB_XCNT(b.x)], 1u);
    return b;
}
__device__ __forceinline__ void xcd_barrier_complete(unsigned* bar, unsigned x, unsigned& nloc, unsigned& nx) {
    const unsigned G = gridDim.x * gridDim.y * gridDim.z;
    unsigned sum, cnt, mine, sp = 0u;
    for (;;) {
        sum = 0u; cnt = 0u; mine = 0u;
#pragma unroll
        for (unsigned j = 0; j < 16; ++j) { const unsigned c = xb_ld(&bar[XB_XCNT(j)]); sum += c; cnt += (c > 0u) ? 1u : 0u; mine = (j == x) ? c : mine; }
        if (sum == G) break;
        __builtin_amdgcn_s_sleep(1);
        if ((++sp & 255u) == 0u) { if (xb_ld(&bar[XB_TMO])) break; if (sp > XB_SPIN_CAP) { atomicAdd(&bar[XB_TMO], 1u); break; } }
    }
    nloc = mine > 0u ? mine : 1u; nx = cnt > 0u ? cnt : 1u;
}

__device__ __forceinline__ void xcd_barrier(const XcdBarrier& b) {
    asm volatile("s_waitcnt vmcnt(0)" ::: "memory");
    __syncthreads();
    if (threadIdx.x == 0) {
        unsigned* bar = b.bar;
        __builtin_amdgcn_s_waitcnt(0);
        unsigned nloc = b.st[0], nx = b.st[1];
        if (nloc == 0u) { xcd_barrier_complete(bar, b.x, nloc, nx); b.st[0] = nloc; b.st[1] = nx; }
        const unsigned old = xb_add(&bar[XB_XSUB(b.x)], 1u);
        const unsigned gen = old / nloc;
        if (old + 1u == (gen + 1u) * nloc) {
            __builtin_amdgcn_fence(__ATOMIC_RELEASE, "agent");
            asm volatile("s_waitcnt vmcnt(0)" ::: "memory");
            const unsigned og = xb_add(&bar[XB_TOP], 1u);
            const unsigned tg = og / nx;
            if (og + 1u == (tg + 1u) * nx) xb_add(&bar[XB_TOPGEN], 1u);
            else XB_SPIN(xb_ld(&bar[XB_TOPGEN]) == tg, bar);
            __builtin_amdgcn_fence(__ATOMIC_ACQUIRE, "agent");
            xb_add(&bar[XB_XGEN(b.x)], 1u);
            asm volatile("s_waitcnt vmcnt(0)" ::: "memory");
        } else {
            XB_SPIN(xb_ld(&bar[XB_XGEN(b.x)]) == gen, bar);
            __builtin_amdgcn_fence(__ATOMIC_ACQUIRE, "agent");
            asm volatile("s_waitcnt vmcnt(0)" ::: "memory");
        }
    }
    __syncthreads();
}

struct Args { In in; float* out; unsigned char* ws; int ph_lo, ph_hi; };
constexpr int NPHASE = 12;
__global__ void __launch_bounds__(NWAVES * 64, 2) fwd_kernel(Args a) {
    extern __shared__ __attribute__((aligned(16))) unsigned char lds_raw[];
    LAS unsigned char* lds = (LAS unsigned char*)lds_raw;
    const int tid = threadIdx.x, lane = tid & 63, wave = __builtin_amdgcn_readfirstlane(tid >> 6);
    const int G = gridDim.x, gw = blockIdx.x * NWAVES + wave, NGW = G * NWAVES;
    unsigned char* ws = a.ws; const In& I = a.in;
    float* mod = (float*)(ws + WS_MOD);
    bf16_t* A = (bf16_t*)(ws + WS_A); bf16_t* H = (bf16_t*)(ws + WS_H);
    const int lo = a.ph_lo, hi = a.ph_hi;
#define IN(k) (lo <= (k) && (k) < hi)
#if MK_MULTI
#define SEAM(k) do { } while (0)
#else
    volatile LAS unsigned* MISC = (volatile LAS unsigned*)(lds + MISC_OFF);
    if (tid < 16) MISC[tid] = 0u;
    __syncthreads();
    XcdBarrier xbar = xcd_barrier_post((unsigned*)(ws + WS_BAR), MISC);
#define SEAM(k) do { if (IN(k) && IN((k) + 1)) { xcd_barrier(xbar); } } while (0)
#endif
    if (IN(0)) { p0_prologue(I, ws, lds, gw, NGW, wave, lane, true); if (PROBE_DUP == 0) p0_prologue(I, ws, lds, gw, NGW, wave, lane, false); } SEAM(0);
    if (IN(1)) for (int rep_ = 0; rep_ < (PROBE_DUP == 1 ? 2 : 1); ++rep_) { norm_mod_rows(I.x, I.g_ffn1, mod, 0, 1, A, gw, NGW, lane); } SEAM(1);
    if (IN(2)) for (int rep_ = 0; rep_ < (PROBE_DUP == 2 ? 2 : 1); ++rep_) { pg8::Gemm g{A, (const bf16_t*)(ws + WS_WGU1), M_, 2 * FF_, D_}; pg8::StaticOrder S; S.init(M_, 2 * FF_, G, (int)blockIdx.x); pg8::EpiSwiGLU E{H};
        pg8::gemm_phase<pg8::EpiSwiGLU, pg8::StaticOrder, true, true, false, true>(lds, g, S, E); if (rep_ == 0) tail_convert(I, ws, lds, G, wave, lane, 1, TR_N1); } SEAM(2);
    if (IN(3)) for (int rep_ = 0; rep_ < (PROBE_DUP == 3 ? 2 : 1); ++rep_) { pg8::Gemm g{H, (const bf16_t*)(ws + WS_WD1), M_, D_, FF_}; pg8::StaticOrder S; S.init(M_, D_, G, (int)blockIdx.x, 4); pg8::EpiResid<false, true, 1> E{I.x, ws + WS_HB, mod + 2 * D_};
        pg8::gemm_phase<pg8::EpiResid<false, true, 1>, pg8::StaticOrder, true, true, true, true>(lds, g, S, E); } SEAM(3);
    if (IN(4)) { norm_mod_rows_bf((const bf16_t*)(ws + WS_HB), I.g_mix, mod, 3, 4, A, gw, NGW, lane); } SEAM(4);
    if (IN(5)) for (int rep_ = 0; rep_ < (PROBE_DUP == 5 ? 2 : 1); ++rep_) { pg8::Gemm g{A, (const bf16_t*)(ws + WS_WQKV), M_, 3 * D_, D_}; pg8::StaticOrder S; S.init(M_, 3 * D_, G, (int)blockIdx.x, 4);
        pg8::EpiQKV E{(bf16_t*)(ws + WS_Q), (float*)(ws + WS_SSQ), (const float*)(ws + WS_GAIN), (const float*)(ws + WS_ROPE)};
        pg8::gemm_phase<pg8::EpiQKV, pg8::StaticOrder, true, true, false, true>(lds, g, S, E); } SEAM(5);
    if (IN(6)) for (int rep_ = 0; rep_ < (PROBE_DUP == 6 ? 2 : 1); ++rep_) { AttnT T{(const bf16_t*)(ws + WS_Q), (const bf16_t*)(ws + WS_K), (const bf16_t*)(ws + WS_V), (const float*)(ws + WS_SSQ), I.rpb_na, (bf16_t*)(ws + WS_ONA), (bf16_t*)(ws + WS_ODIL), (float*)(ws + WS_LSE)};
        attn_phase(lds, T, G); } SEAM(6);
    if (IN(7)) for (int rep_ = 0; rep_ < (PROBE_DUP == 7 ? 2 : 1); ++rep_) { combine_rows((const bf16_t*)(ws + WS_ONA), (const bf16_t*)(ws + WS_ODIL), (const float*)(ws + WS_LSE), I.g_out_na, I.g_out_dil, A, gw, NGW, lane); } SEAM(7);
    if (IN(8)) { pg8::Gemm g{A, (const bf16_t*)(ws + WS_WO), M_, D_, D_}; pg8::StaticOrder S; S.init(M_, D_, G, (int)blockIdx.x, 4); pg8::EpiResid<true, true, 2> E{ws + WS_HB, ws + WS_HB, mod + 5 * D_};
        pg8::gemm_phase<pg8::EpiResid<true, true, 2>, pg8::StaticOrder, true, true, false, true>(lds, g, S, E); } SEAM(8);
    if (IN(9)) { norm_mod_rows_bf((const bf16_t*)(ws + WS_HB), I.g_ffn2, mod, 6, 7, A, gw, NGW, lane); } SEAM(9);
    if (IN(10)) { pg8::Gemm g{A, (const bf16_t*)(ws + WS_WGU2), M_, 2 * FF_, D_}; pg8::StaticOrder S; S.init(M_, 2 * FF_, G, (int)blockIdx.x); pg8::EpiSwiGLU E{H};
        pg8::gemm_phase<pg8::EpiSwiGLU, pg8::StaticOrder, true, true, false, true>(lds, g, S, E); tail_convert(I, ws, lds, G, wave, lane, 2, TR_N2); } SEAM(10);
    if (IN(11)) { pg8::Gemm g{H, (const bf16_t*)(ws + WS_WD2), M_, D_, FF_}; pg8::StaticOrder S; S.init(M_, D_, G, (int)blockIdx.x, 4); pg8::EpiResid<true, false, 1> E{ws + WS_HB, a.out, mod + 8 * D_};
        pg8::gemm_phase<pg8::EpiResid<true, false, 1>, pg8::StaticOrder, true, true, true, true>(lds, g, S, E); }
#undef IN
#undef SEAM
}

extern "C" void kernel_launch(void* const* d_in, const int* in_sizes, int n_in, void* d_out, int out_size, void* d_ws, size_t ws_size, hipStream_t stream) {
    static int grid = 0;
    if (grid == 0) {
        if (n_in != 22 || out_size != M_ * D_ || ws_size < WS_END) { fprintf(stderr, "kernel_launch: unexpected shapes (n_in %d out %d ws %zu)\n", n_in, out_size, ws_size); grid = -1; return; }
        int dev = 0, cus = 0, per_cu = 0;
        (void)hipGetDevice(&dev); (void)hipDeviceGetAttribute(&cus, hipDeviceAttributeMultiprocessorCount, dev);
        if (hipFuncSetAttribute((const void*)fwd_kernel, hipFuncAttributeMaxDynamicSharedMemorySize, LDS_BYTES) != hipSuccess) { fprintf(stderr, "kernel_launch: hipFuncSetAttribute failed\n"); grid = -1; return; }
        if (hipOccupancyMaxActiveBlocksPerMultiprocessor(&per_cu, (const void*)fwd_kernel, NWAVES * 64, LDS_BYTES) != hipSuccess || per_cu < 1) { fprintf(stderr, "kernel_launch: occupancy query failed (%d)\n", per_cu); (void)hipGetLastError(); per_cu = 1; }
        grid = cus * per_cu;
    }
    if (grid < 0) return;
    (void)hipMemsetAsync((char*)d_ws + WS_MOD, 0, WS_ZERO_BYTES, stream);
    Args a{};
    const float** ip = (const float**)&a.in;
    for (int i = 0; i < 22; ++i) ip[i] = (const float*)d_in[i];
    a.out = (float*)d_out; a.ws = (unsigned char*)d_ws;
#if MK_MULTI
    for (int ph = 0; ph < NPHASE; ++ph) { a.ph_lo = ph; a.ph_hi = ph + 1; hipLaunchKernelGGL(fwd_kernel, dim3(grid), dim3(NWAVES * 64), LDS_BYTES, stream, a); }
#else
    a.ph_lo = 0; a.ph_hi = NPHASE;
    void* args[] = {&a};
    hipError_t e = hipLaunchCooperativeKernel((const void*)fwd_kernel, dim3(grid), dim3(NWAVES * 64), args, LDS_BYTES, stream);
    if (e != hipSuccess) fprintf(stderr, "cooperative launch failed: %s (grid %d)\n", hipGetErrorString(e), grid);
#endif
}
```

```cpp
#include <hip/hip_runtime.h>
#include <hip/hip_cooperative_groups.h>
#include <cstdio>
#include <cstdint>
namespace cg = cooperative_groups;

#ifndef PROBE_DUP
#define PROBE_DUP -1
#endif
#ifndef MK_MULTI
#define MK_MULTI 0
#endif

namespace pg8 {
#define PG8_LAS __attribute__((address_space(3)))
typedef unsigned short bf16_t;
typedef short bf16x8 __attribute__((ext_vector_type(8)));
typedef float f32x4 __attribute__((ext_vector_type(4)));
typedef unsigned u32x4 __attribute__((ext_vector_type(4)));
constexpr int BM = 256, BK = 64, HALF = 128, HTB = HALF * BK * 2  , STAGE_BYTES = 8 * HTB, NXCD = 8, WGM = 8;

__host__ __device__ __forceinline__ int lds_byte(int r, int c) { const int st = (r >> 4) * 2 + (c >> 5), rr = r & 15, cc = c & 31, ob = rr * 64 + cc * 2; return st * 1024 + (ob ^ (((ob >> 9) & 1) << 5)); }
__host__ __device__ __forceinline__ void stage_rc(int b, int& R, int& C) { const int st = b / 1024, sb = b % 1024, swz = sb ^ (((sb >> 9) & 1) << 5); R = (st >> 1) * 16 + swz / 64; C = (st & 1) * 32 + (swz % 64) / 2; }
__host__ __device__ __forceinline__ int perm32(int rho) { const int n = rho >> 4, i = rho & 15; return 8 * (i >> 2) + 4 * n + (i & 3); }

struct Unit { int pm, pn; };
struct Gemm { const bf16_t* A; const bf16_t* Bt; int M, N, K; };

struct StaticOrder {
    int nM, nN, nwg, G, c, wgm;
    __host__ __device__ void init(int M, int N, int G_, int c_, int wgm_ = WGM) { nM = M / BM; nN = N / BM; nwg = nM * nN; G = G_; c = c_; wgm = wgm_; }
    __host__ __device__ bool next(int i, Unit& u) const {
        const long L = (long)i * G + c; if (L >= nwg) return false;
        int wgid = (int)L; { const int q = nwg / NXCD, r = nwg % NXCD, xcd = wgid % NXCD, off = wgid / NXCD; wgid = (xcd < r ? xcd * (q + 1) : r * (q + 1) + (xcd - r) * q) + off; }
        const int nig = wgm * nN, gid = wgid / nig, fm = gid * wgm, gsz = (nM - fm) < wgm ? (nM - fm) : wgm;
        u.pm = fm + ((wgid % nig) % gsz); u.pn = (wgid % nig) / gsz; return true;
    }
    __device__ __forceinline__ void a_ready(const Unit&) const {}
    __device__ __forceinline__ void done(const Unit&) const {}
};

__device__ __forceinline__ unsigned cvt_pk_bf16(float lo, float hi) { unsigned r; asm volatile("v_cvt_pk_bf16_f32 %0, %1, %2" : "=v"(r) : "v"(lo), "v"(hi)); return r; }
__device__ __forceinline__ float silu_f(float g) { return g * __builtin_amdgcn_rcpf(1.0f + __builtin_amdgcn_exp2f(-1.4426950408889634f * g)); }

constexpr int EM = 8192, ED = 2048, EFF = 5632, ENMOD = 18432, ESEQ = 4096;

struct EpiSwiGLU {
    static constexpr bool PERM = true, AFTER_DRAIN = false;
    bf16_t* H;
    __device__ __forceinline__ void operator()(const f32x4 (&acc)[2][2][4][2], const Unit& u, int wr, int wc, int fr, int fq) const {
        const int row0 = u.pm * BM + wr * 64 + fr, col0 = u.pn * 128 + wc * 32 + 8 * fq;
#pragma unroll
        for (int ai = 0; ai < 2; ++ai)
#pragma unroll
            for (int m = 0; m < 4; ++m) {
                const int rr = row0 + ai * HALF + m * 16;
                bf16_t* rowp = H + (((size_t)(rr >> 8) * (EFF / 64) + (col0 >> 6)) * 256 + (rr & 255)) * 64 + (col0 & 63);
                const f32x4 g0 = acc[ai][0][m][0], g1 = acc[ai][0][m][1], u0 = acc[ai][1][m][0], u1 = acc[ai][1][m][1];
                u32x4 w;
                w.x = cvt_pk_bf16(silu_f(g0[0]) * u0[0], silu_f(g0[1]) * u0[1]); w.y = cvt_pk_bf16(silu_f(g0[2]) * u0[2], silu_f(g0[3]) * u0[3]);
                w.z = cvt_pk_bf16(silu_f(g1[0]) * u1[0], silu_f(g1[1]) * u1[1]); w.w = cvt_pk_bf16(silu_f(g1[2]) * u1[2], silu_f(g1[3]) * u1[3]);
                *(u32x4*)rowp = w;
            }
    }
};
typedef _Float16 h16x2_t __attribute__((ext_vector_type(2)));
typedef float f32x2e_t __attribute__((ext_vector_type(2)));
__device__ __forceinline__ unsigned pk_h16(float a, float b) { const f32x2e_t v = {a, b}; const h16x2_t h = __builtin_convertvector(v, h16x2_t); return __builtin_bit_cast(unsigned, h); }
__device__ __forceinline__ f32x2e_t up_h16(unsigned w) { const h16x2_t h = __builtin_bit_cast(h16x2_t, w); return __builtin_convertvector(h, f32x2e_t); }
template <bool BIN, bool BOUT, int GS2>
struct EpiResid {
    static constexpr bool PERM = true, AFTER_DRAIN = false;
    const void* base; void* out; const float* gate;
    __device__ __forceinline__ void operator()(const f32x4 (&acc)[2][2][4][2], const Unit& u, int wr, int wc, int fr, int fq) const {
        const int row0 = u.pm * BM + wr * 64 + fr, col0 = u.pn * BM + wc * 32 + 8 * fq, b = u.pm >> 4;
        f32x4 gv[2][2];
#pragma unroll
        for (int bj = 0; bj < 2; ++bj)
#pragma unroll
            for (int n = 0; n < 2; ++n) gv[bj][n] = *(const f32x4*)(gate + (size_t)b * ENMOD + col0 + bj * HALF + 4 * n) * (0.5f * GS2);
#pragma unroll
        for (int ai = 0; ai < 2; ++ai) {
            f32x4 bsf[4][2][2]; u32x4 bsw[4][2];
#pragma unroll
            for (int m = 0; m < 4; ++m) { const size_t off = (size_t)(row0 + ai * HALF + m * 16) * ED + col0;
#pragma unroll
                for (int bj = 0; bj < 2; ++bj) { const size_t o2 = off + bj * HALF;
                    if (BIN) bsw[m][bj] = __builtin_nontemporal_load((const u32x4*)((const bf16_t*)base + o2));
                    else { bsf[m][bj][0] = __builtin_nontemporal_load((const f32x4*)((const float*)base + o2)); bsf[m][bj][1] = __builtin_nontemporal_load((const f32x4*)((const float*)base + o2 + 4)); } } }
#pragma unroll
            for (int m = 0; m < 4; ++m) { const size_t off = (size_t)(row0 + ai * HALF + m * 16) * ED + col0;
#pragma unroll
                for (int bj = 0; bj < 2; ++bj) { const size_t o2 = off + bj * HALF; f32x4 b0, b1;
                    if (BIN) { const u32x4 w = bsw[m][bj];
                        const f32x2e_t u0 = up_h16(w.x), u1 = up_h16(w.y), u2 = up_h16(w.z), u3 = up_h16(w.w);
                        b0 = (f32x4){u0.x, u0.y, u1.x, u1.y}; b1 = (f32x4){u2.x, u2.y, u3.x, u3.y}; }
                    else { b0 = bsf[m][bj][0]; b1 = bsf[m][bj][1]; }
                    const f32x4 h0 = b0 + gv[bj][0] * acc[ai][bj][m][0], h1 = b1 + gv[bj][1] * acc[ai][bj][m][1];
                    if (BOUT) { u32x4 w; w.x = pk_h16(h0[0], h0[1]); w.y = pk_h16(h0[2], h0[3]); w.z = pk_h16(h1[0], h1[1]); w.w = pk_h16(h1[2], h1[3]); *(u32x4*)((bf16_t*)out + o2) = w; }
                    else { __builtin_nontemporal_store(h0, (f32x4*)((float*)out + o2)); __builtin_nontemporal_store(h1, (f32x4*)((float*)out + o2 + 4)); } } }
            asm volatile("" ::: "memory");
        }
    }
};
struct EpiQKV {
    static constexpr bool PERM = true, AFTER_DRAIN = false;
    bf16_t* QKV; float* ssq; const float* gains; const float* rope;
    __device__ __forceinline__ void operator()(const f32x4 (&acc)[2][2][4][2], const Unit& u, int wr, int wc, int fr, int fq) const {
        const int row0 = u.pm * BM + wr * 64 + fr;
        const int kind = u.pn >> 3, pl = u.pn & 7;
        bf16_t* dst = QKV + (size_t)kind * ((size_t)EM * ED);
        const int cbase = pl * 256 + wc * 32 + 8 * fq;
        if (kind == 2) {
#pragma unroll
            for (int ai = 0; ai < 2; ++ai)
#pragma unroll
                for (int m = 0; m < 4; ++m) { bf16_t* rowp = dst + (size_t)(row0 + ai * HALF + m * 16) * ED + cbase;
#pragma unroll
                    for (int bj = 0; bj < 2; ++bj) { const f32x4 v0 = acc[ai][bj][m][0], v1 = acc[ai][bj][m][1]; u32x4 w;
                        w.x = cvt_pk_bf16(v0[0], v0[1]); w.y = cvt_pk_bf16(v0[2], v0[3]); w.z = cvt_pk_bf16(v1[0], v1[1]); w.w = cvt_pk_bf16(v1[2], v1[3]);
                        *(u32x4*)(rowp + bj * HALF) = w; } }
            return;
        }
        const bool dil = pl >= 4;
        const float* gn = gains + (kind * 2 + (dil ? 1 : 0)) * 128;
        f32x4 g0, g1;
        if (wc == 0) { g0 = *(const f32x4*)(gn + 4 * fq); g1 = *(const f32x4*)(gn + 16 + 4 * fq); }
        else { g0 = *(const f32x4*)(gn + wc * 32 + 8 * fq); g1 = *(const f32x4*)(gn + wc * 32 + 8 * fq + 4); }
        const bool do_rope = dil && wc == 0;
#pragma unroll
        for (int ai = 0; ai < 2; ++ai)
#pragma unroll
            for (int m = 0; m < 4; ++m) {
                const int row = row0 + ai * HALF + m * 16;
                f32x4 cs0 = {1.f, 0.f, 1.f, 0.f}, cs1 = {1.f, 0.f, 1.f, 0.f};
                if (do_rope) { const float* rp = rope + ((size_t)(row & (ESEQ - 1)) * 16 + 4 * fq) * 2; cs0 = *(const f32x4*)rp; cs1 = *(const f32x4*)(rp + 4); }
#pragma unroll
                for (int bj = 0; bj < 2; ++bj) {
                    const f32x4 r0 = acc[ai][bj][m][0], r1 = acc[ai][bj][m][1];
                    float ss = (r0[0] * r0[0] + r0[1] * r0[1]) + (r0[2] * r0[2] + r0[3] * r0[3]) + (r1[0] * r1[0] + r1[1] * r1[1]) + (r1[2] * r1[2] + r1[3] * r1[3]);
                    ss += __shfl_xor(ss, 16); ss += __shfl_xor(ss, 32);
                    const int head = 2 * pl + bj;
                    if (fq == 0) ssq[(size_t)(wc * 32 + kind * 16 + head) * EM + row] = ss;
                    f32x4 x1 = r0 * g0, x2 = r1 * g1;
                    if (do_rope) {
                        const f32x4 c = {cs0[0], cs0[2], cs1[0], cs1[2]}, s = {cs0[1], cs0[3], cs1[1], cs1[3]};
                        const f32x4 y1 = x1 * c - x2 * s, y2 = x2 * c + x1 * s; x1 = y1; x2 = y2;
                    }
                    u32x4 w; w.x = cvt_pk_bf16(x1[0], x1[1]); w.y = cvt_pk_bf16(x1[2], x1[3]); w.z = cvt_pk_bf16(x2[0], x2[1]); w.w = cvt_pk_bf16(x2[2], x2[3]);
                    *(u32x4*)(dst + (size_t)row * ED + cbase + bj * HALF) = w;
                }
            }
    }
};

template <class Epi, class Sched, bool ALIGN_EPI = false, bool SP2 = false, bool BLKA = false, bool BLKB = false>
__device__ __forceinline__ void gemm_phase(PG8_LAS unsigned char* lds, const Gemm g, const Sched& S, const Epi& E) {
    const int tid = threadIdx.x, wid = __builtin_amdgcn_readfirstlane(tid >> 6), lane = tid & 63, wr = wid >> 2, wc = wid & 3, fr = lane & 15, fq = lane >> 4;
    const int K = g.K, nt = K / BK;
    unsigned voffA[2], voffB[2];
#pragma unroll
    for (int i = 0; i < 2; ++i) { int R, C; stage_rc(tid * 16 + i * 8192, R, C); const int Rb = Epi::PERM ? ((R & ~31) + perm32(R & 31)) : R;
        voffA[i] = (unsigned)(R * (BLKA ? BK : K) + C) * 2u; voffB[i] = (unsigned)(Rb * (BLKB ? BK : K) + C) * 2u; }
    const size_t kstepA = BLKA ? (size_t)(BM * BK * 2) : (size_t)(BK * 2), kstepB = BLKB ? (size_t)(BM * BK * 2) : (size_t)(BK * 2);
    const size_t hstepA = BLKA ? (size_t)(HALF * BK * 2) : (size_t)HALF * K * 2, hstepB = BLKB ? (size_t)(HALF * BK * 2) : (size_t)HALF * K * 2;
    const size_t tstep = (size_t)BM * K * 2;
    const unsigned ldsw = (unsigned)wid * 1024u;
    const int aoff = lds_byte(wr * 64 + fr, fq * 8), boff = lds_byte(wc * 32 + fr, fq * 8);
#define PG8_SA(b, h) (((b) * 2 + (h)) * HTB)
#define PG8_SB(b, h) ((4 + (b) * 2 + (h)) * HTB)
#define PG8_STAGE(bufoff, gbase, voff) do { _Pragma("unroll") for (int _i = 0; _i < 2; ++_i) \
        __builtin_amdgcn_global_load_lds((const unsigned*)((const char*)(gbase) + (voff)[_i]), (PG8_LAS unsigned*)(lds + (bufoff) + ldsw + _i * 8192), 16, 0, 0); } while (0)
#define PG8_LDA(dst, b, h) do { _Pragma("unroll") for (int m = 0; m < 4; ++m) _Pragma("unroll") for (int k = 0; k < 2; ++k) dst[m][k] = *(const PG8_LAS bf16x8*)(lds + PG8_SA(b, h) + aoff + m * 2048 + k * 1024); } while (0)
#define PG8_LDB(dst, b, h) do { _Pragma("unroll") for (int n = 0; n < 2; ++n) _Pragma("unroll") for (int k = 0; k < 2; ++k) dst[n][k] = *(const PG8_LAS bf16x8*)(lds + PG8_SB(b, h) + boff + n * 2048 + k * 1024); } while (0)
#define PG8_MMA(ai, bj, At, Bt) do { __builtin_amdgcn_s_setprio(1); _Pragma("unroll") for (int m = 0; m < 4; ++m) _Pragma("unroll") for (int n = 0; n < 2; ++n) _Pragma("unroll") for (int k = 0; k < 2; ++k) \
        acc[ai][bj][m][n] = __builtin_amdgcn_mfma_f32_16x16x32_bf16(Bt[n][k], At[m][k], acc[ai][bj][m][n], 0, 0, 0); __builtin_amdgcn_s_setprio(0); } while (0)
#define PG8_WAIT_V(n) asm volatile("s_waitcnt vmcnt(" #n ")" ::: "memory")
#define PG8_WAIT_L(n) asm volatile("s_waitcnt lgkmcnt(" #n ")" ::: "memory")
#define PG8_BAR __builtin_amdgcn_s_barrier()
#define PG8_SCHED __builtin_amdgcn_sched_barrier(0)
    Unit cur, nxt; int ui = 0;
    if (!S.next(0, cur)) return;
    f32x4 acc[2][2][4][2];
#pragma unroll
    for (int a = 0; a < 2; ++a)
#pragma unroll
        for (int b = 0; b < 2; ++b)
#pragma unroll
            for (int m = 0; m < 4; ++m)
#pragma unroll
                for (int n = 0; n < 2; ++n) acc[a][b][m][n] = (f32x4){0.f, 0.f, 0.f, 0.f};
    bf16x8 At[4][2], B0[2][2], B1[2][2];
    const char* cA = (const char*)g.A + (size_t)cur.pm * tstep; const char* cB = (const char*)g.Bt + (size_t)cur.pn * tstep;
    S.a_ready(cur);
    if constexpr (SP2) {
        PG8_STAGE(PG8_SB(0, 0), cB, voffB); PG8_STAGE(PG8_SB(0, 1), cB + hstepB, voffB); PG8_STAGE(PG8_SA(0, 0), cA, voffA); PG8_STAGE(PG8_SA(0, 1), cA + hstepA, voffA);
        if (wr == 1) PG8_BAR;
        PG8_WAIT_V(2); PG8_BAR;
        PG8_STAGE(PG8_SB(1, 0), cB + kstepB, voffB); PG8_STAGE(PG8_SA(1, 0), cA + kstepA, voffA); PG8_STAGE(PG8_SB(1, 1), cB + hstepB + kstepB, voffB);
        PG8_WAIT_V(6); PG8_BAR;
    } else {
        PG8_STAGE(PG8_SB(0, 0), cB, voffB); PG8_STAGE(PG8_SA(0, 0), cA, voffA); PG8_STAGE(PG8_SB(0, 1), cB + hstepB, voffB); PG8_STAGE(PG8_SA(0, 1), cA + hstepA, voffA);
        if (wr == 1) PG8_BAR;
        PG8_WAIT_V(4); PG8_BAR;
        PG8_STAGE(PG8_SB(1, 0), cB + kstepB, voffB); PG8_STAGE(PG8_SA(1, 0), cA + kstepA, voffA); PG8_STAGE(PG8_SB(1, 1), cB + hstepB + kstepB, voffB);
        PG8_WAIT_V(6); PG8_BAR;
    }
    for (;;) {
        const bool has_next = S.next(ui + 1, nxt);
        const char* nA = has_next ? (const char*)g.A + (size_t)nxt.pm * tstep : cA; const char* nB = has_next ? (const char*)g.Bt + (size_t)nxt.pn * tstep : cB;
        for (int t = 0; t < nt; t += 2) {
            const bool last = (t == nt - 2);
            const char* a1 = cA + (size_t)(t + 1) * kstepA;
            const char* a2 = last ? nA : cA + (size_t)(t + 2) * kstepA; const char* b2 = last ? nB : cB + (size_t)(t + 2) * kstepB;
            const char* a3 = a2 + kstepA; const char* b3 = b2 + kstepB;
            if (last && has_next) S.a_ready(nxt);
            if constexpr (SP2) {
            PG8_LDB(B0, 0, 0); PG8_LDB(B1, 0, 1); PG8_SCHED; PG8_LDA(At, 0, 0); PG8_STAGE(PG8_SA(1, 1), a1 + hstepA, voffA);
            PG8_WAIT_V(8); PG8_WAIT_L(0); PG8_BAR; PG8_MMA(0, 0, At, B0); PG8_MMA(0, 1, At, B1); PG8_BAR; PG8_SCHED;
            PG8_LDA(At, 0, 1); PG8_STAGE(PG8_SB(0, 0), b2, voffB); PG8_STAGE(PG8_SB(0, 1), b2 + hstepB, voffB); PG8_STAGE(PG8_SA(0, 0), a2, voffA);
            PG8_WAIT_V(8); PG8_WAIT_L(0); PG8_BAR; PG8_MMA(1, 0, At, B0); PG8_MMA(1, 1, At, B1); PG8_BAR; PG8_SCHED;
            PG8_LDB(B0, 1, 0); PG8_LDB(B1, 1, 1); PG8_SCHED; PG8_LDA(At, 1, 0); PG8_STAGE(PG8_SA(0, 1), a2 + hstepA, voffA);
            PG8_WAIT_V(8); PG8_WAIT_L(0); PG8_BAR; PG8_MMA(0, 0, At, B0); PG8_MMA(0, 1, At, B1); PG8_BAR; PG8_SCHED;
            PG8_LDA(At, 1, 1); PG8_STAGE(PG8_SB(1, 0), b3, voffB); PG8_STAGE(PG8_SB(1, 1), b3 + hstepB, voffB); PG8_STAGE(PG8_SA(1, 0), a3, voffA);
            PG8_WAIT_V(8); PG8_WAIT_L(0); PG8_BAR; PG8_MMA(1, 0, At, B0); PG8_MMA(1, 1, At, B1); PG8_BAR; PG8_SCHED;
            } else {
            PG8_LDB(B0, 0, 0); PG8_SCHED; PG8_LDA(At, 0, 0); PG8_STAGE(PG8_SA(1, 1), a1 + hstepA, voffA);
            PG8_WAIT_L(8); PG8_BAR; PG8_WAIT_L(0); PG8_MMA(0, 0, At, B0); PG8_BAR; PG8_SCHED;
            PG8_LDB(B1, 0, 1); PG8_STAGE(PG8_SB(0, 0), b2, voffB);
            PG8_BAR; PG8_WAIT_L(0); PG8_MMA(0, 1, At, B1); PG8_BAR;
            PG8_LDA(At, 0, 1); PG8_STAGE(PG8_SA(0, 0), a2, voffA);
            PG8_BAR; PG8_WAIT_L(0); PG8_MMA(1, 0, At, B0); PG8_BAR; PG8_SCHED;
            PG8_STAGE(PG8_SB(0, 1), b2 + hstepB, voffB);
            PG8_WAIT_V(6); PG8_BAR; PG8_MMA(1, 1, At, B1); PG8_BAR;
            PG8_LDB(B0, 1, 0); PG8_SCHED; PG8_LDA(At, 1, 0); PG8_STAGE(PG8_SA(0, 1), a2 + hstepA, voffA);
            PG8_WAIT_L(8); PG8_BAR; PG8_WAIT_L(0); PG8_MMA(0, 0, At, B0); PG8_BAR; PG8_SCHED;
            PG8_LDB(B1, 1, 1); PG8_STAGE(PG8_SB(1, 0), b3, voffB);
            PG8_BAR; PG8_WAIT_L(0); PG8_MMA(0, 1, At, B1); PG8_BAR;
            PG8_LDA(At, 1, 1); PG8_STAGE(PG8_SA(1, 0), a3, voffA);
            PG8_BAR; PG8_WAIT_L(0); PG8_MMA(1, 0, At, B0); PG8_BAR; PG8_SCHED;
            PG8_STAGE(PG8_SB(1, 1), b3 + hstepB, voffB);
            PG8_WAIT_V(6); PG8_BAR; PG8_MMA(1, 1, At, B1); PG8_BAR;
            }
        }
        if constexpr (ALIGN_EPI) { if (wr == 0) PG8_BAR; }
        if constexpr (!Epi::AFTER_DRAIN) { E(acc, cur, wr, wc, fr, fq); S.done(cur); }
        if (!has_next) break;
#pragma unroll
        for (int a = 0; a < 2; ++a)
#pragma unroll
            for (int b = 0; b < 2; ++b)
#pragma unroll
                for (int m = 0; m < 4; ++m)
#pragma unroll
                    for (int n = 0; n < 2; ++n) acc[a][b][m][n] = (f32x4){0.f, 0.f, 0.f, 0.f};
        cur = nxt; cA = nA; cB = nB; ++ui;
        if constexpr (ALIGN_EPI) { if (wr == 1) PG8_BAR; }
    }
    PG8_WAIT_V(0);
    if constexpr (!ALIGN_EPI) { if (wr == 0) PG8_BAR; }
    PG8_BAR;
    if constexpr (Epi::AFTER_DRAIN) { E.fused(acc, cur, wr, wc, fr, fq, lds, wid, lane); S.done(cur); }
#undef PG8_SA
#undef PG8_SB
#undef PG8_STAGE
#undef PG8_LDA
#undef PG8_LDB
#undef PG8_MMA
#undef PG8_WAIT_V
#undef PG8_WAIT_L
#undef PG8_BAR
#undef PG8_SCHED
}
}
using pg8::bf16_t; using pg8::bf16x8; using pg8::f32x4; using pg8::u32x4;
#define LAS __attribute__((address_space(3)))
typedef short s16x4 __attribute__((ext_vector_type(4)));
typedef float f32x2_t __attribute__((ext_vector_type(2))); typedef __bf16 bf16x2_t __attribute__((ext_vector_type(2)));
typedef unsigned u32x2 __attribute__((ext_vector_type(2)));
__device__ __forceinline__ unsigned cvtpk_s(float lo, float hi) { f32x2_t v = {lo, hi}; bf16x2_t b = __builtin_convertvector(v, bf16x2_t); return __builtin_bit_cast(unsigned, b); }
__device__ __forceinline__ float bf2f(unsigned short h) { return __uint_as_float((unsigned)h << 16); }
__device__ __forceinline__ float bflo(unsigned w) { return __uint_as_float(w << 16); }
__device__ __forceinline__ float bfhi(unsigned w) { return __uint_as_float(w & 0xffff0000u); }
__device__ __forceinline__ float wave_sum(float v) {
#pragma unroll
    for (int o = 1; o < 64; o <<= 1) v += __shfl_xor(v, o);
    return v;
}

constexpr int M_ = 8192, D_ = 2048, FF_ = 5632, SEQ_ = 4096, NMOD_ = 18432;
constexpr float EPS_ = 1e-6f;
constexpr size_t MiB = 1u << 20;
constexpr size_t WS_MOD = 0;
constexpr size_t WS_BAR = 160 * 1024;
constexpr size_t WS_ZERO_BYTES = 256 * 1024;
constexpr int MISC_OFF = 147456 - 64;
constexpr size_t WS_ROPE = 1 * MiB;
constexpr size_t WS_GAIN = 1 * MiB + 512 * 1024;
constexpr size_t WS_SSQ = 2 * MiB;
constexpr size_t WS_LSE = 6 * MiB;
constexpr size_t WS_WGU1 = 8 * MiB, WS_WD1 = 52 * MiB, WS_WQKV = 74 * MiB, WS_WO = 98 * MiB, WS_WGU2 = 106 * MiB, WS_WD2 = 150 * MiB;
constexpr size_t WS_A = 172 * MiB;
constexpr size_t WS_H = 204 * MiB;
constexpr size_t WS_Q = 292 * MiB, WS_K = 324 * MiB, WS_V = 356 * MiB;
constexpr size_t WS_ONA = 388 * MiB;
constexpr size_t WS_ODIL = 404 * MiB;
constexpr size_t WS_HB = 452 * MiB;
constexpr size_t WS_END = 484 * MiB;
constexpr int LDS_BYTES = 147456;
constexpr int NWAVES = 8;

__device__ __forceinline__ int pos_of(int d) { return d < 16 ? 8 * (d >> 2) + (d & 3) : 8 * ((d - 16) >> 2) + 4 + (d & 3); }
__device__ __forceinline__ void tr_item(const float* __restrict__ W, int K, int N, bf16_t* WT, int mode, LAS float* scr, int item, int lane, bool blk = false) {
    const int nblk = N / 32, kb = item / nblk, nb = item - kb * nblk, k0 = 64 * kb, n0 = 32 * nb;
#pragma unroll 16
    for (int i = 0; i < 32; ++i) { const int kk = 2 * i + (lane >> 5); scr[kk * 33 + (lane & 31)] = W[(size_t)(k0 + kk) * N + n0 + (lane & 31)]; }
    asm volatile("s_waitcnt lgkmcnt(0)" ::: "memory");
    const int c = lane & 7;
    int rb = n0; bool perm = false;
    if (mode == 1) rb = ((n0 >> 7) << 8) + (n0 & 127); else if (mode == 2) rb = ((n0 >> 7) << 8) + 128 + (n0 & 127); else if (mode == 3) perm = (n0 < 4096) && ((n0 & 127) == 0);
#pragma unroll
    for (int j = 0; j < 4; ++j) { const int n = (lane >> 3) + 8 * j; const LAS float* s = scr + (8 * c) * 33 + n;
        u32x4 o; o.x = cvtpk_s(s[0 * 33], s[1 * 33]); o.y = cvtpk_s(s[2 * 33], s[3 * 33]); o.z = cvtpk_s(s[4 * 33], s[5 * 33]); o.w = cvtpk_s(s[6 * 33], s[7 * 33]);
        const int dr = rb + (perm ? pos_of(n) : n);
        const size_t di = blk ? ((((size_t)(dr >> 8) * (K >> 6) + (k0 >> 6)) * 256 + (dr & 255)) * 64 + 8 * c) : ((size_t)dr * K + k0 + 8 * c);
        *(u32x4*)(WT + di) = o; }
    asm volatile("s_waitcnt lgkmcnt(0)" ::: "memory");
}
__device__ __forceinline__ void mod_item(const float* __restrict__ cvec, const float* __restrict__ w_ada, const float* __restrict__ b_ada, float* mod, int item, int lane) {
    const int cg_ = item % 72, kc = item / 72, col = cg_ * 256 + lane * 4;
    const float* W = w_ada + (size_t)(kc * 128) * NMOD_ + col;
    f32x4 a0 = {0.f, 0.f, 0.f, 0.f}, a1 = {0.f, 0.f, 0.f, 0.f};
    for (int k = 0; k < 128; k += 8) {
        f32x4 w[8];
#pragma unroll
        for (int j = 0; j < 8; ++j) w[j] = __builtin_nontemporal_load((const f32x4*)(W + (size_t)(k + j) * NMOD_));
#pragma unroll
        for (int j = 0; j < 8; ++j) { const float c0 = pg8::silu_f(cvec[kc * 128 + k + j]), c1 = pg8::silu_f(cvec[D_ + kc * 128 + k + j]); a0 += w[j] * c0; a1 += w[j] * c1; }
    }
    if (kc == 0) { const f32x4 bb = *(const f32x4*)(b_ada + col); a0 += bb; a1 += bb; }
#pragma unroll
    for (int i = 0; i < 4; ++i) { __hip_atomic_fetch_add(mod + col + i, a0[i], __ATOMIC_RELAXED, __HIP_MEMORY_SCOPE_AGENT); __hip_atomic_fetch_add(mod + NMOD_ + col + i, a1[i], __ATOMIC_RELAXED, __HIP_MEMORY_SCOPE_AGENT); }
}
__device__ const float ROPE_INV[16] = {1.0f, 0.44036659598350525f, 0.1939227432012558f, 0.08539710193872452f, 0.03760603070259094f, 0.016560440883040428f, 0.007292664609849453f, 0.0032114461064338684f,
    0.0014142135623842478f, 0.0006227724370546639f, 0.00027424818836152554f, 0.00012076973507646471f, 5.3182957344688475e-05f, 2.34199997066753e-05f, 1.0313385246263351e-05f, 4.541670477919979e-06f};
__device__ __forceinline__ void rope_entry(float* rope, int idx) {
    const int pos = idx >> 4, f = idx & 15;
    const float inv = ROPE_INV[f];
    const float ang = (float)pos * inv;
    const double x = (double)ang;
    const double q = rint(x * 0.63661977236758134308);
    double y = fma(-q, 1.57079632679489655800, x); y = fma(-q, 6.12323399573676603587e-17, y);
    const double y2 = y * y;
    double sp = -2.50521083854417187751e-08; sp = fma(sp, y2, 2.75573192239858906526e-06); sp = fma(sp, y2, -1.98412698412698412698e-04); sp = fma(sp, y2, 8.33333333333333333333e-03); sp = fma(sp, y2, -1.66666666666666666667e-01);
    const double sn = fma(y * y2, sp, y);
    double cp = 2.08767569878680989792e-09; cp = fma(cp, y2, -2.75573192239858906526e-07); cp = fma(cp, y2, 2.48015873015873015873e-05); cp = fma(cp, y2, -1.38888888888888888889e-03); cp = fma(cp, y2, 4.16666666666666666667e-02); cp = fma(cp, y2, -0.5);
    const double cn = fma(y2, cp, 1.0);
    const int qi = ((int)q) & 3;
    const double s = (qi == 0) ? sn : (qi == 1) ? cn : (qi == 2) ? -sn : -cn;
    const double c = (qi == 0) ? cn : (qi == 1) ? -sn : (qi == 2) ? -cn : sn;
    rope[2 * idx] = (float)c; rope[2 * idx + 1] = (float)s;
}
struct In { const float *x, *c, *w_ada, *b_ada, *g_ffn1, *w1_gate, *w1_up, *w1_down, *g_mix, *w_qkv, *qn_na, *kn_na, *qn_dil, *kn_dil, *rpb_na, *g_out_na, *g_out_dil, *w_o, *g_ffn2, *w2_gate, *w2_up, *w2_down; };
struct TrD { const float* W; bf16_t* WT; int K, N, mode, blk, item; };
__device__ __forceinline__ TrD tr_desc(const In& I, unsigned char* ws, int list, int it) {
    constexpr int NG = 5632; TrD d; d.blk = 1; d.mode = 0; d.K = D_; d.N = FF_; d.item = it; d.W = I.w1_gate; d.WT = (bf16_t*)(ws + WS_WGU1);
    if (list == 0) {
        if (it < NG) { d.mode = 1; }
        else if (it < 2 * NG) { d.W = I.w1_up; d.mode = 2; d.item = it - NG; }
        else if (it < 2 * NG + 2048) { d.W = I.w_o; d.WT = (bf16_t*)(ws + WS_WO); d.N = D_; d.item = it - 2 * NG; }
        else if (it < 3 * NG + 2048) { d.W = I.w2_gate; d.WT = (bf16_t*)(ws + WS_WGU2); d.mode = 1; d.item = it - 2 * NG - 2048; }
        else { d.W = I.w2_up; d.WT = (bf16_t*)(ws + WS_WGU2); d.mode = 2; d.item = it - 3 * NG - 2048; }
    } else if (list == 1) {
        if (it < NG) { d.W = I.w1_down; d.WT = (bf16_t*)(ws + WS_WD1); d.K = FF_; d.N = D_; d.blk = 1; }
        else { d.W = I.w_qkv; d.WT = (bf16_t*)(ws + WS_WQKV); d.N = 3 * D_; d.mode = 3; d.item = it - NG; }
    } else { d.W = I.w2_down; d.WT = (bf16_t*)(ws + WS_WD2); d.K = FF_; d.N = D_; d.blk = 1; }
    return d;
}
__device__ __forceinline__ void tr_load(const TrD& d, f32x4 (&v)[8], int lane) {
    const int nblk = d.N / 32, kb = d.item / nblk, nb = d.item - kb * nblk, k0 = 64 * kb, n0 = 32 * nb, kl = lane & 7, nl = lane >> 3;
    const float* p = d.W + (size_t)(k0 + 8 * kl) * d.N + n0 + 4 * nl;
#pragma unroll
    for (int e = 0; e < 8; ++e) v[e] = __builtin_nontemporal_load((const f32x4*)(p + (size_t)e * d.N));
}
__device__ __forceinline__ void tr_store(const TrD& d, const f32x4 (&v)[8], int lane) {
    const int nblk = d.N / 32, kb = d.item / nblk, nb = d.item - kb * nblk, k0 = 64 * kb, n0 = 32 * nb, kl = lane & 7, nl = lane >> 3, K = d.K;
    int rb = n0; bool perm = false;
    if (d.mode == 1) rb = ((n0 >> 7) << 8) + (n0 & 127); else if (d.mode == 2) rb = ((n0 >> 7) << 8) + 128 + (n0 & 127); else if (d.mode == 3) perm = (n0 < 4096) && ((n0 & 127) == 0);
#pragma unroll
    for (int i = 0; i < 4; ++i) { const int n = 4 * nl + i, dr = rb + (perm ? pos_of(n) : n);
        u32x4 o; o.x = cvtpk_s(v[0][i], v[1][i]); o.y = cvtpk_s(v[2][i], v[3][i]); o.z = cvtpk_s(v[4][i], v[5][i]); o.w = cvtpk_s(v[6][i], v[7][i]);
        const size_t di = d.blk ? ((((size_t)(dr >> 8) * (K >> 6) + (k0 >> 6)) * 256 + (dr & 255)) * 64 + 8 * kl) : ((size_t)dr * K + k0 + 8 * kl);
        *(u32x4*)(d.WT + di) = o; }
}
__device__ __forceinline__ void tr_run(const In& I, unsigned char* ws, int list, int it0, int step, int end, int lane) {
    int it = it0;
    for (; it + step < end; it += 2 * step) { const TrD a = tr_desc(I, ws, list, it), b = tr_desc(I, ws, list, it + step); f32x4 va[8], vb[8];
        tr_load(a, va, lane); tr_load(b, vb, lane); tr_store(a, va, lane); tr_store(b, vb, lane); }
    if (it < end) { const TrD a = tr_desc(I, ws, list, it); f32x4 va[8]; tr_load(a, va, lane); tr_store(a, va, lane); }
}
constexpr int TR_N0 = 4 * 5632 + 2048, TR_N1 = 5632 + 6144, TR_N2 = 5632;
__device__ __forceinline__ void p0_prologue(const In& I, unsigned char* ws, LAS unsigned char* lds, int gw, int NGW, int wave, int lane, bool do_mod) {
    LAS float* scr = (LAS float*)(lds + wave * 16384);
    float* mod = (float*)(ws + WS_MOD);
    if (do_mod) for (int it = gw; it < 72 * 16; it += NGW) mod_item(I.c, I.w_ada, I.b_ada, mod, it, lane);
    if (NGW == 2048) {
        tr_run(I, ws, 0, gw, 2048, 7 * 2048, lane);
        if (gw >= 1152) tr_run(I, ws, 0, 7 * 2048 + (gw - 1152), 896, TR_N0, lane);
    } else tr_run(I, ws, 0, gw, NGW, TR_N0, lane);
    float* rope = (float*)(ws + WS_ROPE);
    for (int idx = gw * 64 + lane; idx < SEQ_ * 16; idx += NGW * 64) rope_entry(rope, idx);
    if (gw == 0) { float* gains = (float*)(ws + WS_GAIN); gains[lane] = I.qn_na[lane]; gains[64 + lane] = I.qn_na[64 + lane]; gains[128 + lane] = I.qn_dil[lane]; gains[192 + lane] = I.qn_dil[64 + lane];
        gains[256 + lane] = I.kn_na[lane]; gains[320 + lane] = I.kn_na[64 + lane]; gains[384 + lane] = I.kn_dil[lane]; gains[448 + lane] = I.kn_dil[64 + lane]; }
}
__device__ __forceinline__ void tail_convert(const In& I, unsigned char* ws, LAS unsigned char* lds, int G, int wave, int lane, int list, int nitems) {
    const int nwg = (M_ / 256) * (2 * FF_ / 256), rounds = (nwg + G - 1) / G, busy = nwg - (rounds - 1) * G;
    int nidle = G - busy, my = (int)blockIdx.x - busy;
    if (nidle <= 0) { nidle = G; my = (int)blockIdx.x; }
    if (my < 0) return;
    tr_run(I, ws, list, my * NWAVES + wave, nidle * NWAVES, nitems, lane);
}

__device__ __forceinline__ void norm_mod_rows(const float* src, const float* __restrict__ g, const float* mod, int sh_idx, int sc_idx, bf16_t* A, int gw, int NGW, int lane) {
    for (int row = gw; row < M_; row += NGW) {
        const int b = row >> 12;
        const f32x4* xr = (const f32x4*)(src + (size_t)row * D_) + lane;
        f32x4 v[8]; float ss = 0.f;
#pragma unroll
        for (int j = 0; j < 8; ++j) { v[j] = __builtin_nontemporal_load(xr + 64 * j); ss += (v[j][0] * v[j][0] + v[j][1] * v[j][1]) + (v[j][2] * v[j][2] + v[j][3] * v[j][3]); }
        const float r = __builtin_amdgcn_rsqf(wave_sum(ss) * (1.f / D_) + EPS_);
        const float* sh = mod + (size_t)b * NMOD_ + sh_idx * D_; const float* sc = mod + (size_t)b * NMOD_ + sc_idx * D_;
        u32x2* o = (u32x2*)(A + (size_t)row * D_) + lane;
#pragma unroll
        for (int j = 0; j < 8; ++j) { const int k = 4 * lane + 256 * j; const f32x4 gg = *(const f32x4*)(g + k), s1 = *(const f32x4*)(sc + k), s0 = *(const f32x4*)(sh + k);
            const f32x4 y = v[j] * r * gg * (s1 + 1.0f) + s0; u32x2 w; w.x = cvtpk_s(y[0], y[1]); w.y = cvtpk_s(y[2], y[3]); o[64 * j] = w; }
    }
}

__device__ __forceinline__ void norm_mod_rows_bf(const bf16_t* src, const float* __restrict__ g, const float* mod, int sh_idx, int sc_idx, bf16_t* A, int gw, int NGW, int lane) {
    for (int row = gw; row < M_; row += NGW) {
        const int b = row >> 12;
        const u32x4* xr = (const u32x4*)(src + (size_t)row * D_) + lane;
        f32x4 v[4][2]; float ss = 0.f;
#pragma unroll
        for (int j = 0; j < 4; ++j) { const u32x4 w = __builtin_nontemporal_load(xr + 64 * j); { const pg8::f32x2e_t u0 = pg8::up_h16(w.x), u1 = pg8::up_h16(w.y), u2 = pg8::up_h16(w.z), u3 = pg8::up_h16(w.w); v[j][0] = (f32x4){u0.x, u0.y, u1.x, u1.y}; v[j][1] = (f32x4){u2.x, u2.y, u3.x, u3.y}; }
#pragma unroll
            for (int e = 0; e < 2; ++e) ss += (v[j][e][0] * v[j][e][0] + v[j][e][1] * v[j][e][1]) + (v[j][e][2] * v[j][e][2] + v[j][e][3] * v[j][e][3]); }
        const float r = __builtin_amdgcn_rsqf(wave_sum(ss) * (1.f / D_) + EPS_);
        const float* sh = mod + (size_t)b * NMOD_ + sh_idx * D_; const float* sc = mod + (size_t)b * NMOD_ + sc_idx * D_;
        u32x4* o = (u32x4*)(A + (size_t)row * D_) + lane;
#pragma unroll
        for (int j = 0; j < 4; ++j) { const int k = 8 * lane + 512 * j; f32x4 y[2];
#pragma unroll
            for (int e = 0; e < 2; ++e) { const f32x4 gg = *(const f32x4*)(g + k + 4 * e), s1 = *(const f32x4*)(sc + k + 4 * e), s0 = *(const f32x4*)(sh + k + 4 * e); y[e] = v[j][e] * r * gg * (s1 + 1.0f) + s0; }
            u32x4 w; w.x = cvtpk_s(y[0][0], y[0][1]); w.y = cvtpk_s(y[0][2], y[0][3]); w.z = cvtpk_s(y[1][0], y[1][1]); w.w = cvtpk_s(y[1][2], y[1][3]); o[64 * j] = w; }
    }
}

constexpr int KROW = 272;
constexpr int KB_OFF = 0, VB_OFF = 256 * KROW, RK_OFF = 2 * 256 * KROW;
typedef short v4i16_t __attribute__((ext_vector_type(4)));
__device__ __forceinline__ s16x4 vtr(LAS const unsigned char* p) { return __builtin_bit_cast(s16x4, __builtin_amdgcn_ds_read_tr16_b64_v4i16((LAS v4i16_t*)p)); }
#define MFMA16(a, b, c) __builtin_amdgcn_mfma_f32_16x16x32_bf16((a), (b), (c), 0, 0, 0)
struct AttnT { const bf16_t *Q, *K, *V; const float* ssq; const float* rpb; bf16_t* ONA; bf16_t* ODIL; float* LSE; };

constexpr int BIAS_OFF = RK_OFF + 1024;
struct UD { int na, b, r, hp, rs, h, p, dd, rho, sb, nsb; };
__device__ __forceinline__ UD decode_unit(int u) {
    UD d; d.na = u < 512; d.r = 0; d.hp = 0; d.rs = 0; d.h = 0; d.p = 0; d.dd = 1; d.rho = 0; d.sb = 0; d.nsb = 1;
    if (d.na) { d.hp = u & 3; d.r = (u >> 2) & 63; d.b = u >> 8; d.rs = min(max(d.r - 4, 0), 56); }
    else { const int v = u - 512, blk = v & 31; d.p = (v >> 5) % 3; d.h = (v / 96) & 7; d.b = v / 768; const int sh2 = 2 * d.p; d.dd = 1 << sh2; d.rho = blk & (d.dd - 1); d.sb = blk >> sh2; d.nsb = 32 >> sh2; }
    return d;
}
struct CD { int b, tbase, smask, dd, hbase, hsel; };
__device__ __forceinline__ CD chunk_desc(const UD& d, int ck) {
    CD c; c.b = d.b; c.dd = d.dd;
    c.tbase = d.na ? (d.rs + 2 * ck) * 64 : d.rho + (128 * d.sb - 64) * d.dd;
    c.smask = d.na ? 127 : 255; c.hbase = d.na ? 2 * d.hp : 8 + d.h; c.hsel = d.na ? 1 : 0;
    return c;
}
struct Pre { u32x4 k[8]; f32x4 ks4; bf16x8 qf[4]; f32x4 qs4; float bias; };
__device__ __forceinline__ void prefetch_chunk(Pre& P, const AttnT& T, const CD& cd, int tid) {
    const unsigned char* Kg = (const unsigned char*)T.K;
    const int piece = tid & 15;
#pragma unroll
    for (int i = 0; i < 8; ++i) { const int slot = (tid >> 4) + 32 * i;
        const int token = min(max(cd.tbase + (slot & cd.smask) * cd.dd, 0), SEQ_ - 1), khead = cd.hbase + ((slot >> 7) & cd.hsel);
        const unsigned goff = (unsigned)(((cd.b * SEQ_ + token) * D_ + khead * 128) * 2 + piece * 16);
        P.k[i] = *(const u32x4*)(Kg + goff); }
    { const int slot = tid & 255; const int token = min(max(cd.tbase + (slot & cd.smask) * cd.dd, 0), SEQ_ - 1), khead = cd.hbase + ((slot >> 7) & cd.hsel);
        const float* sp = T.ssq + (unsigned)((16 + khead) * M_ + cd.b * SEQ_ + token); P.ks4 = (f32x4){sp[0], sp[32 * M_], sp[64 * M_], sp[96 * M_]}; }
}
__device__ __forceinline__ void load_v(u32x4 (&v)[8], const AttnT& T, const CD& cd, int tid) {
    const unsigned char* Vg = (const unsigned char*)T.V; const int piece = tid & 15;
#pragma unroll
    for (int i = 0; i < 8; ++i) { const int slot = (tid >> 4) + 32 * i;
        const int token = min(max(cd.tbase + (slot & cd.smask) * cd.dd, 0), SEQ_ - 1), khead = cd.hbase + ((slot >> 7) & cd.hsel);
        v[i] = *(const u32x4*)(Vg + (unsigned)(((cd.b * SEQ_ + token) * D_ + khead * 128) * 2 + piece * 16)); }
}
__device__ __forceinline__ void unit_query(const UD& d, int w, int c, int& jq, int& tq, int& head) {
    jq = 16 * (w & (d.na ? 3 : 7)) + c; tq = (d.na ? d.r * 64 : d.rho + 128 * d.sb * d.dd) + jq * d.dd; head = d.na ? 2 * d.hp + (w >> 2) : 8 + d.h;
}
__device__ __forceinline__ void prefetch_q(Pre& P, const AttnT& T, const UD& d, int w, int lane, int tid) {
    int jq, tq, head; unit_query(d, w, lane & 15, jq, tq, head);
    const unsigned rowQ = (unsigned)(d.b * SEQ_ + tq);
    const unsigned char* qp = (const unsigned char*)T.Q + (unsigned)((rowQ * D_ + head * 128 + 8 * (lane >> 4)) * 2);
#pragma unroll
    for (int ks = 0; ks < 4; ++ks) P.qf[ks] = *(const bf16x8*)(qp + 64 * ks);
    { const float* sp = T.ssq + (unsigned)(head * M_) + rowQ; P.qs4 = (f32x4){sp[0], sp[32 * M_], sp[64 * M_], sp[96 * M_]}; }
    { const int hh2 = tid >> 8, i8 = (tid >> 5) & 7, co = min(tid & 31, 30);
      P.bias = T.rpb[((2 * d.hp + hh2) * 15 + (d.rs + i8 - d.r + 7)) * 31 + co] * 1.4426950408889634f; }
}
template <bool NA>
__device__ __forceinline__ void attn_unit(LAS unsigned char* lds, const AttnT& T, const UD& d, const UD& nxt, bool has_next, Pre& P) {
    constexpr int NT = NA ? 4 : 10, NCH = NA ? 4 : 1;
    const int tid = threadIdx.x, lane = tid & 63, w = __builtin_amdgcn_readfirstlane(tid >> 6), c = lane & 15, g = lane >> 4;
    const int hh = w >> 2, qg = w & 3;
    int jq, tq, head; unit_query(d, w, c, jq, tq, head);
    const size_t rowQ = (size_t)d.b * SEQ_ + tq;
    if (NA) prefetch_q(P, T, d, w, lane, tid);
    bf16x8 qf[4];
#pragma unroll
    for (int ks = 0; ks < 4; ++ks) qf[ks] = P.qf[ks];
    const float rq = __builtin_amdgcn_rsqf(((P.qs4[0] + P.qs4[1]) + (P.qs4[2] + P.qs4[3])) * (1.f / 128.f) + EPS_) * (0.08838834764831845f * 1.4426950408889634f);
    const float biasv = P.bias;
    const int W0 = NA ? (qg == 0 ? 0 : qg == 1 ? 8 : qg == 2 ? 24 : 32) : 0;
    const int cs = min(max(jq - 8, 0), 48);
    const int lo_s = (!NA && d.sb == 0) ? 64 : 0, hi_s = (!NA && d.sb == d.nsb - 1) ? 192 : 256;
    f32x4 O[8];
#pragma unroll
    for (int dt = 0; dt < 8; ++dt) O[dt] = (f32x4){0.f, 0.f, 0.f, 0.f};
    float m_run = -1e30f, l_run = 0.f;
    LAS float* rk = (LAS float*)(lds + RK_OFF);
#pragma unroll 1
    for (int ck = 0; ck < NCH; ++ck) {
        u32x4 vreg[8]; load_v(vreg, T, chunk_desc(d, ck), tid);
#pragma unroll
        for (int i = 0; i < 8; ++i) { const int slot = (tid >> 4) + 32 * i, piece = tid & 15;
            *(LAS u32x4*)(lds + KB_OFF + slot * KROW + piece * 16) = P.k[i]; }
        if (tid < 256) rk[tid] = __builtin_amdgcn_rsqf(((P.ks4[0] + P.ks4[1]) + (P.ks4[2] + P.ks4[3])) * (1.f / 128.f) + EPS_);
        if (NA && ck == 0) ((LAS float*)(lds + BIAS_OFF))[tid] = biasv;
        __syncthreads();
        { const CD cdn = (ck + 1 < NCH) ? chunk_desc(d, ck + 1) : chunk_desc(nxt, 0); if (ck + 1 < NCH || has_next) prefetch_chunk(P, T, cdn, tid); }
        f32x4 s[NT]; float mx = -1e30f;
#pragma unroll
        for (int t = 0; t < NT; ++t) {
            const int tb = NA ? hh * 128 + (t >> 1) * 64 + W0 + 16 * (t & 1) : 16 * w + 16 * t;
            if (!NA && t == 9) { s[t] = (f32x4){-1e30f, -1e30f, -1e30f, -1e30f}; continue; }
            f32x4 acc = {0.f, 0.f, 0.f, 0.f};
#pragma unroll
            for (int ks = 0; ks < 4; ++ks) { const bf16x8 a = *(const LAS bf16x8*)(lds + KB_OFF + (tb + c) * KROW + (32 * ks + 8 * g) * 2); acc = MFMA16(a, qf[ks], acc); }
            const f32x4 rk4 = *(const LAS f32x4*)(lds + RK_OFF + (tb + 4 * g) * 4);
#pragma unroll
            for (int i = 0; i < 4; ++i) {
                float v = acc[i] * rq * rk4[i]; bool valid;
                if (NA) { const int kc = W0 + 16 * (t & 1) + 4 * g + i; valid = (kc >= cs) && (kc < cs + 16);
                    const int co = min(max(kc - jq + 15, 0), 30);
                    v += *(const LAS float*)(lds + BIAS_OFF + ((hh * 8 + 2 * ck + (t >> 1)) * 32 + co) * 4); }
                else { const int slot = tb + 4 * g + i; valid = (slot >= lo_s) && (slot < hi_s);
                    if (t == 0) valid = valid && (4 * g + i >= c);
                    if (t == 8) valid = valid && (4 * g + i <= c); }
                v = valid ? v : -1e30f; acc[i] = v; mx = fmaxf(mx, v);
            }
            s[t] = acc;
        }
        if (!NA && ck + 1 >= NCH && has_next) prefetch_q(P, T, nxt, w, lane, tid);
        mx = fmaxf(mx, __shfl_xor(mx, 16)); mx = fmaxf(mx, __shfl_xor(mx, 32));
        const float m_new = fmaxf(m_run, mx), alpha = __builtin_amdgcn_exp2f(m_run - m_new);
        float ls = 0.f;
#pragma unroll
        for (int t = 0; t < NT; ++t)
#pragma unroll
            for (int i = 0; i < 4; ++i) { const float pv = __builtin_amdgcn_exp2f(s[t][i] - m_new); s[t][i] = pv; ls += pv; }
        ls += __shfl_xor(ls, 16); ls += __shfl_xor(ls, 32);
        l_run = l_run * alpha + ls; m_run = m_new;
        if (NA) {
#pragma unroll
            for (int dt = 0; dt < 8; ++dt) O[dt] *= alpha;
        }
#pragma unroll
        for (int i = 0; i < 8; ++i) { const int slot = (tid >> 4) + 32 * i, piece = tid & 15; *(LAS u32x4*)(lds + VB_OFF + slot * KROW + piece * 16) = vreg[i]; }
        __syncthreads();
#pragma unroll
        for (int u = 0; u < NT / 2; ++u) {
            const int t0 = 2 * u, t1 = 2 * u + 1;
            int tb0 = NA ? hh * 128 + (t0 >> 1) * 64 + W0 + 16 * (t0 & 1) : 16 * w + 16 * t0;
            int tb1 = NA ? hh * 128 + (t1 >> 1) * 64 + W0 + 16 * (t1 & 1) : 16 * w + 16 * t1;
            if (!NA) { tb0 = min(tb0, 240); tb1 = min(tb1, 240); }
            u32x4 pw; pw.x = cvtpk_s(s[t0][0], s[t0][1]); pw.y = cvtpk_s(s[t0][2], s[t0][3]); pw.z = cvtpk_s(s[t1][0], s[t1][1]); pw.w = cvtpk_s(s[t1][2], s[t1][3]);
            const bf16x8 pb = __builtin_bit_cast(bf16x8, pw);
            LAS const unsigned char* v0 = lds + VB_OFF + (tb0 + 4 * g + (c >> 2)) * KROW + 8 * (c & 3);
            LAS const unsigned char* v1 = lds + VB_OFF + (tb1 + 4 * g + (c >> 2)) * KROW + 8 * (c & 3);
#pragma unroll
            for (int dt = 0; dt < 8; ++dt) { const s16x4 lo = vtr(v0 + 32 * dt), hi = vtr(v1 + 32 * dt);
                const bf16x8 a = {lo[0], lo[1], lo[2], lo[3], hi[0], hi[1], hi[2], hi[3]}; O[dt] = MFMA16(a, pb, O[dt]); }
        }
    }
    const float inv = __builtin_amdgcn_rcpf(l_run);
    bf16_t* ob = NA ? T.ONA + rowQ * 1024 + head * 128 : T.ODIL + ((size_t)d.p * M_ + rowQ) * 1024 + d.h * 128;
#pragma unroll
    for (int e = 0; e < 4; ++e) {
        const unsigned a0 = cvtpk_s(O[2 * e][0] * inv, O[2 * e][1] * inv), a1 = cvtpk_s(O[2 * e][2] * inv, O[2 * e][3] * inv);
        const unsigned b0 = cvtpk_s(O[2 * e + 1][0] * inv, O[2 * e + 1][1] * inv), b1 = cvtpk_s(O[2 * e + 1][2] * inv, O[2 * e + 1][3] * inv);
        const bool odd = g & 1;
        const unsigned r0 = __shfl_xor(odd ? a0 : b0, 16), r1 = __shfl_xor(odd ? a1 : b1, 16);
        u32x4 wv; if (odd) { wv.x = r0; wv.y = r1; wv.z = b0; wv.w = b1; } else { wv.x = a0; wv.y = a1; wv.z = r0; wv.w = r1; }
        *(u32x4*)(ob + 32 * e + (odd ? 16 + 4 * (g - 1) : 4 * g)) = wv; }
    if (!NA && g == 0) T.LSE[((size_t)d.p * M_ + rowQ) * 8 + d.h] = (m_run + __builtin_amdgcn_logf(l_run)) * 0.6931471805599453f;
}
template <bool NA>
__device__ __forceinline__ int unit_of(int i, int G) {
    const int bx = blockIdx.x;
    if (G != 256) return NA ? bx + i * G : bx + i * G;
    const int x = bx & 7, j = bx >> 3;
    if (NA) return ((x >> 2) << 8) | ((2 * j + i) << 2) | (x & 3);
    const int bh = 2 * x + i / 3, v = j * 3 + (i % 3);
    return bh * 96 + v;
}
template <bool NA>
__device__ __forceinline__ void attn_loop(LAS unsigned char* lds, const AttnT& T, int G) {
    const int nun = NA ? 512 : 1536, ubase = NA ? 0 : 512;
    const int cnt = (G == 256) ? (NA ? 2 : 6) : (nun - (int)blockIdx.x + G - 1) / G;
    if (cnt <= 0) return;
    const int tid = threadIdx.x, lane = tid & 63, w = __builtin_amdgcn_readfirstlane(tid >> 6);
    UD cur = decode_unit(ubase + unit_of<NA>(0, G));
    Pre P; prefetch_chunk(P, T, chunk_desc(cur, 0), tid); if (!NA) prefetch_q(P, T, cur, w, lane, tid);
#pragma unroll 1
    for (int i = 0; i < cnt; ++i) {
        const bool has_next = i + 1 < cnt; const UD nxt = decode_unit(ubase + unit_of<NA>(has_next ? i + 1 : i, G));
        attn_unit<NA>(lds, T, cur, nxt, has_next, P);
        cur = nxt;
    }
    __syncthreads();
}
__device__ __forceinline__ void attn_phase(LAS unsigned char* lds, const AttnT& T, int G) {
    attn_loop<true>(lds, T, G);
    attn_loop<false>(lds, T, G);
}
__device__ __forceinline__ void combine_rows(const bf16_t* ONA, const bf16_t* ODIL, const float* LSE, const float* __restrict__ g_na, const float* __restrict__ g_dil, bf16_t* A, int gw, int NGW, int lane) {
    for (int row = gw; row < M_; row += NGW) {
        float va[2][8], vd[2][8]; float sa = 0.f, sd = 0.f;
#pragma unroll
        for (int j = 0; j < 2; ++j) {
            const int k = 8 * lane + 512 * j;
            const u32x4 x = __builtin_nontemporal_load((const u32x4*)(ONA + (size_t)row * 1024 + k));
            va[j][0] = bflo(x.x); va[j][1] = bfhi(x.x); va[j][2] = bflo(x.y); va[j][3] = bfhi(x.y); va[j][4] = bflo(x.z); va[j][5] = bfhi(x.z); va[j][6] = bflo(x.w); va[j][7] = bfhi(x.w);
            const int hd = k >> 7;
            const float l0 = LSE[((size_t)0 * M_ + row) * 8 + hd], l1 = LSE[((size_t)1 * M_ + row) * 8 + hd], l2 = LSE[((size_t)2 * M_ + row) * 8 + hd];
            const float mm = fmaxf(l0, fmaxf(l1, l2)); float w0 = __expf(l0 - mm), w1 = __expf(l1 - mm), w2 = __expf(l2 - mm); const float wi = 1.f / (w0 + w1 + w2); w0 *= wi; w1 *= wi; w2 *= wi;
            const u32x4 y0 = __builtin_nontemporal_load((const u32x4*)(ODIL + ((size_t)0 * M_ + row) * 1024 + k)), y1 = __builtin_nontemporal_load((const u32x4*)(ODIL + ((size_t)1 * M_ + row) * 1024 + k)), y2 = __builtin_nontemporal_load((const u32x4*)(ODIL + ((size_t)2 * M_ + row) * 1024 + k));
            vd[j][0] = w0 * bflo(y0.x) + w1 * bflo(y1.x) + w2 * bflo(y2.x); vd[j][1] = w0 * bfhi(y0.x) + w1 * bfhi(y1.x) + w2 * bfhi(y2.x);
            vd[j][2] = w0 * bflo(y0.y) + w1 * bflo(y1.y) + w2 * bflo(y2.y); vd[j][3] = w0 * bfhi(y0.y) + w1 * bfhi(y1.y) + w2 * bfhi(y2.y);
            vd[j][4] = w0 * bflo(y0.z) + w1 * bflo(y1.z) + w2 * bflo(y2.z); vd[j][5] = w0 * bfhi(y0.z) + w1 * bfhi(y1.z) + w2 * bfhi(y2.z);
            vd[j][6] = w0 * bflo(y0.w) + w1 * bflo(y1.w) + w2 * bflo(y2.w); vd[j][7] = w0 * bfhi(y0.w) + w1 * bfhi(y1.w) + w2 * bfhi(y2.w);
#pragma unroll
            for (int e = 0; e < 8; ++e) { sa += va[j][e] * va[j][e]; sd += vd[j][e] * vd[j][e]; }
        }
        const float ra = __builtin_amdgcn_rsqf(wave_sum(sa) * (1.f / 1024.f) + EPS_), rd = __builtin_amdgcn_rsqf(wave_sum(sd) * (1.f / 1024.f) + EPS_);
#pragma unroll
        for (int j = 0; j < 2; ++j) {
            const int k = 8 * lane + 512 * j;
            const f32x4 ga0 = *(const f32x4*)(g_na + k), ga1 = *(const f32x4*)(g_na + k + 4), gd0 = *(const f32x4*)(g_dil + k), gd1 = *(const f32x4*)(g_dil + k + 4);
            u32x4 oa, od;
            oa.x = cvtpk_s(va[j][0] * ra * ga0[0], va[j][1] * ra * ga0[1]); oa.y = cvtpk_s(va[j][2] * ra * ga0[2], va[j][3] * ra * ga0[3]);
            oa.z = cvtpk_s(va[j][4] * ra * ga1[0], va[j][5] * ra * ga1[1]); oa.w = cvtpk_s(va[j][6] * ra * ga1[2], va[j][7] * ra * ga1[3]);
            od.x = cvtpk_s(vd[j][0] * rd * gd0[0], vd[j][1] * rd * gd0[1]); od.y = cvtpk_s(vd[j][2] * rd * gd0[2], vd[j][3] * rd * gd0[3]);
            od.z = cvtpk_s(vd[j][4] * rd * gd1[0], vd[j][5] * rd * gd1[1]); od.w = cvtpk_s(vd[j][6] * rd * gd1[2], vd[j][7] * rd * gd1[3]);
            *(u32x4*)(A + (size_t)row * D_ + k) = oa; *(u32x4*)(A + (size_t)row * D_ + 1024 + k) = od;
        }
    }
}

#define XB_TMO      128
#define XB_XCNT(j)  (256  + 64 * (j))
#define XB_XSUB(j)  (1280 + 64 * (j))
#define XB_XGEN(j)  (2304 + 64 * (j))
#define XB_TOP      3328
#define XB_TOPGEN   3392
#define XCD_BAR_WORDS 3456
#define XB_SPIN_CAP (1u << 18)

__device__ __forceinline__ unsigned xb_ld(unsigned* p)              { return __hip_atomic_load(p, __ATOMIC_RELAXED, __HIP_MEMORY_SCOPE_AGENT); }
__device__ __forceinline__ unsigned xb_add(unsigned* p, unsigned v) { return __hip_atomic_fetch_add(p, v, __ATOMIC_RELAXED, __HIP_MEMORY_SCOPE_AGENT); }
__device__ __forceinline__ unsigned xb_xcc_id() { return (unsigned)__builtin_amdgcn_s_getreg((3 << 11) | 20) & 0xFu; }
#define XB_SPIN(cond, bar) do { unsigned _sp = 0; while (cond) { __builtin_amdgcn_s_sleep(1); \
    if ((++_sp & 255u) == 0u) { if (xb_ld(&(bar)[XB_TMO])) break; if (_sp > XB_SPIN_CAP) { atomicAdd(&(bar)[XB_TMO], 1u); break; } } } } while (0)

struct XcdBarrier {
    unsigned* bar; unsigned x;
    volatile LAS unsigned* st;
};

__device__ __forceinline__ XcdBarrier xcd_barrier_post(unsigned* bar, volatile LAS unsigned* st) {
    XcdBarrier b; b.bar = bar; b.x = xb_xcc_id(); b.st = st;
    if (threadIdx.x == 0) (void)xb_add(&bar[XB_XCNT(b.x)], 1u);
    return b;
}
__device__ __forceinline__ void xcd_barrier_complete(unsigned* bar, unsigned x, unsigned& nloc, unsigned& nx) {
    const unsigned G = gridDim.x * gridDim.y * gridDim.z;
    unsigned sum, cnt, mine, sp = 0u;
    for (;;) {
        sum = 0u; cnt = 0u; mine = 0u;
#pragma unroll
        for (unsigned j = 0; j < 16; ++j) { const unsigned c = xb_ld(&bar[XB_XCNT(j)]); sum += c; cnt += (c > 0u) ? 1u : 0u; mine = (j == x) ? c : mine; }
        if (sum == G) break;
        __builtin_amdgcn_s_sleep(1);
        if ((++sp & 255u) == 0u) { if (xb_ld(&bar[XB_TMO])) break; if (sp > XB_SPIN_CAP) { atomicAdd(&bar[XB_TMO], 1u); break; } }
    }
    nloc = mine > 0u ? mine : 1u; nx = cnt > 0u ? cnt : 1u;
}

__device__ __forceinline__ void xcd_barrier(const XcdBarrier& b) {
    asm volatile("s_waitcnt vmcnt(0)" ::: "memory");
    __syncthreads();
    if (threadIdx.x == 0) {
        unsigned* bar = b.bar;
        __builtin_amdgcn_s_waitcnt(0);
        unsigned nloc = b.st[0], nx = b.st[1];
        if (nloc == 0u) { xcd_barrier_complete(bar, b.x, nloc, nx); b.st[0] = nloc; b.st[1] = nx; }
        const unsigned old = xb_add(&bar[XB_XSUB(b.x)], 1u);
        const unsigned gen = old / nloc;
        if (old + 1u == (gen + 1u) * nloc) {
            __builtin_amdgcn_fence(__ATOMIC_RELEASE, "agent");
            asm volatile("s_waitcnt vmcnt(0)" ::: "memory");
            const unsigned og = xb_add(&bar[XB_TOP], 1u);
            const unsigned tg = og / nx;
            if (og + 1u == (tg + 1u) * nx) xb_add(&bar[XB_TOPGEN], 1u);
            else XB_SPIN(xb_ld(&bar[XB_TOPGEN]) == tg, bar);
            __builtin_amdgcn_fence(__ATOMIC_ACQUIRE, "agent");
            xb_add(&bar[XB_XGEN(b.x)], 1u);
            asm volatile("s_waitcnt vmcnt(0)" ::: "memory");
        } else {
            XB_SPIN(xb_ld(&bar[XB_XGEN(b.x)]) == gen, bar);
            __builtin_amdgcn_fence(__ATOMIC_ACQUIRE, "agent");
            asm volatile("s_waitcnt vmcnt(0)" ::: "memory");
        }
    }
    __syncthreads();
}

struct Args { In in; float* out; unsigned char* ws; int ph_lo, ph_hi; };
constexpr int NPHASE = 12;
__global__ void __launch_bounds__(NWAVES * 64, 2) fwd_kernel(Args a) {
    extern __shared__ __attribute__((aligned(16))) unsigned char lds_raw[];
    LAS unsigned char* lds = (LAS unsigned char*)lds_raw;
    const int tid = threadIdx.x, lane = tid & 63, wave = __builtin_amdgcn_readfirstlane(tid >> 6);
    const int G = gridDim.x, gw = blockIdx.x * NWAVES + wave, NGW = G * NWAVES;
    unsigned char* ws = a.ws; const In& I = a.in;
    float* mod = (float*)(ws + WS_MOD);
    bf16_t* A = (bf16_t*)(ws + WS_A); bf16_t* H = (bf16_t*)(ws + WS_H);
    const int lo = a.ph_lo, hi = a.ph_hi;
#define IN(k) (lo <= (k) && (k) < hi)
#if MK_MULTI
#define SEAM(k) do { } while (0)
#else
    volatile LAS unsigned* MISC = (volatile LAS unsigned*)(lds + MISC_OFF);
    if (tid < 16) MISC[tid] = 0u;
    __syncthreads();
    XcdBarrier xbar = xcd_barrier_post((unsigned*)(ws + WS_BAR), MISC);
#define SEAM(k) do { if (IN(k) && IN((k) + 1)) { xcd_barrier(xbar); } } while (0)
#endif
    if (IN(0)) { p0_prologue(I, ws, lds, gw, NGW, wave, lane, true); if (PROBE_DUP == 0) p0_prologue(I, ws, lds, gw, NGW, wave, lane, false); } SEAM(0);
    if (IN(1)) for (int rep_ = 0; rep_ < (PROBE_DUP == 1 ? 2 : 1); ++rep_) { norm_mod_rows(I.x, I.g_ffn1, mod, 0, 1, A, gw, NGW, lane); } SEAM(1);
    if (IN(2)) for (int rep_ = 0; rep_ < (PROBE_DUP == 2 ? 2 : 1); ++rep_) { pg8::Gemm g{A, (const bf16_t*)(ws + WS_WGU1), M_, 2 * FF_, D_}; pg8::StaticOrder S; S.init(M_, 2 * FF_, G, (int)blockIdx.x, 4); pg8::EpiSwiGLU E{H};
        pg8::gemm_phase<pg8::EpiSwiGLU, pg8::StaticOrder, true, true, false, true>(lds, g, S, E); if (rep_ == 0) tail_convert(I, ws, lds, G, wave, lane, 1, TR_N1); } SEAM(2);
    if (IN(3)) for (int rep_ = 0; rep_ < (PROBE_DUP == 3 ? 2 : 1); ++rep_) { pg8::Gemm g{H, (const bf16_t*)(ws + WS_WD1), M_, D_, FF_}; pg8::StaticOrder S; S.init(M_, D_, G, (int)blockIdx.x, 4); pg8::EpiResid<false, true, 1> E{I.x, ws + WS_HB, mod + 2 * D_};
        pg8::gemm_phase<pg8::EpiResid<false, true, 1>, pg8::StaticOrder, true, true, true, true>(lds, g, S, E); } SEAM(3);
    if (IN(4)) { norm_mod_rows_bf((const bf16_t*)(ws + WS_HB), I.g_mix, mod, 3, 4, A, gw, NGW, lane); } SEAM(4);
    if (IN(5)) for (int rep_ = 0; rep_ < (PROBE_DUP == 5 ? 2 : 1); ++rep_) { pg8::Gemm g{A, (const bf16_t*)(ws + WS_WQKV), M_, 3 * D_, D_}; pg8::StaticOrder S; S.init(M_, 3 * D_, G, (int)blockIdx.x, 4);
        pg8::EpiQKV E{(bf16_t*)(ws + WS_Q), (float*)(ws + WS_SSQ), (const float*)(ws + WS_GAIN), (const float*)(ws + WS_ROPE)};
        pg8::gemm_phase<pg8::EpiQKV, pg8::StaticOrder, true, true, false, true>(lds, g, S, E); } SEAM(5);
    if (IN(6)) for (int rep_ = 0; rep_ < (PROBE_DUP == 6 ? 2 : 1); ++rep_) { AttnT T{(const bf16_t*)(ws + WS_Q), (const bf16_t*)(ws + WS_K), (const bf16_t*)(ws + WS_V), (const float*)(ws + WS_SSQ), I.rpb_na, (bf16_t*)(ws + WS_ONA), (bf16_t*)(ws + WS_ODIL), (float*)(ws + WS_LSE)};
        attn_phase(lds, T, G); } SEAM(6);
    if (IN(7)) for (int rep_ = 0; rep_ < (PROBE_DUP == 7 ? 2 : 1); ++rep_) { combine_rows((const bf16_t*)(ws + WS_ONA), (const bf16_t*)(ws + WS_ODIL), (const float*)(ws + WS_LSE), I.g_out_na, I.g_out_dil, A, gw, NGW, lane); } SEAM(7);
    if (IN(8)) { pg8::Gemm g{A, (const bf16_t*)(ws + WS_WO), M_, D_, D_}; pg8::StaticOrder S; S.init(M_, D_, G, (int)blockIdx.x, 4); pg8::EpiResid<true, true, 2> E{ws + WS_HB, ws + WS_HB, mod + 5 * D_};
        pg8::gemm_phase<pg8::EpiResid<true, true, 2>, pg8::StaticOrder, true, true, false, true>(lds, g, S, E); } SEAM(8);
    if (IN(9)) { norm_mod_rows_bf((const bf16_t*)(ws + WS_HB), I.g_ffn2, mod, 6, 7, A, gw, NGW, lane); } SEAM(9);
    if (IN(10)) { pg8::Gemm g{A, (const bf16_t*)(ws + WS_WGU2), M_, 2 * FF_, D_}; pg8::StaticOrder S; S.init(M_, 2 * FF_, G, (int)blockIdx.x, 4); pg8::EpiSwiGLU E{H};
        pg8::gemm_phase<pg8::EpiSwiGLU, pg8::StaticOrder, true, true, false, true>(lds, g, S, E); tail_convert(I, ws, lds, G, wave, lane, 2, TR_N2); } SEAM(10);
    if (IN(11)) { pg8::Gemm g{H, (const bf16_t*)(ws + WS_WD2), M_, D_, FF_}; pg8::StaticOrder S; S.init(M_, D_, G, (int)blockIdx.x, 4); pg8::EpiResid<true, false, 1> E{ws + WS_HB, a.out, mod + 8 * D_};
        pg8::gemm_phase<pg8::EpiResid<true, false, 1>, pg8::StaticOrder, true, true, true, true>(lds, g, S, E); }
#undef IN
#undef SEAM
}

extern "C" void kernel_launch(void* const* d_in, const int* in_sizes, int n_in, void* d_out, int out_size, void* d_ws, size_t ws_size, hipStream_t stream) {
    static int grid = 0;
    if (grid == 0) {
        if (n_in != 22 || out_size != M_ * D_ || ws_size < WS_END) { fprintf(stderr, "kernel_launch: unexpected shapes (n_in %d out %d ws %zu)\n", n_in, out_size, ws_size); grid = -1; return; }
        int dev = 0, cus = 0, per_cu = 0;
        (void)hipGetDevice(&dev); (void)hipDeviceGetAttribute(&cus, hipDeviceAttributeMultiprocessorCount, dev);
        if (hipFuncSetAttribute((const void*)fwd_kernel, hipFuncAttributeMaxDynamicSharedMemorySize, LDS_BYTES) != hipSuccess) { fprintf(stderr, "kernel_launch: hipFuncSetAttribute failed\n"); grid = -1; return; }
        if (hipOccupancyMaxActiveBlocksPerMultiprocessor(&per_cu, (const void*)fwd_kernel, NWAVES * 64, LDS_BYTES) != hipSuccess || per_cu < 1) { fprintf(stderr, "kernel_launch: occupancy query failed (%d)\n", per_cu); (void)hipGetLastError(); per_cu = 1; }
        grid = cus * per_cu;
    }
    if (grid < 0) return;
    (void)hipMemsetAsync((char*)d_ws + WS_MOD, 0, WS_ZERO_BYTES, stream);
    Args a{};
    const float** ip = (const float**)&a.in;
    for (int i = 0; i < 22; ++i) ip[i] = (const float*)d_in[i];
    a.out = (float*)d_out; a.ws = (unsigned char*)d_ws;
#if MK_MULTI
    for (int ph = 0; ph < NPHASE; ++ph) { a.ph_lo = ph; a.ph_hi = ph + 1; hipLaunchKernelGGL(fwd_kernel, dim3(grid), dim3(NWAVES * 64), LDS_BYTES, stream, a); }
#else
    a.ph_lo = 0; a.ph_hi = NPHASE;
    void* args[] = {&a};
    hipError_t e = hipLaunchCooperativeKernel((const void*)fwd_kernel, dim3(grid), dim3(NWAVES * 64), args, LDS_BYTES, stream);
    if (e != hipSuccess) fprintf(stderr, "cooperative launch failed: %s (grid %d)\n", hipGetErrorString(e), grid);
#endif
}
```
